# Optimizing an MI355X kernel written in HIP

```python
import math
import jax, jax.numpy as jnp
from jax import lax
import numpy as np

D_MODEL = 1024
BATCH = 32
SEQ = 2048
DEPTH = 4
DEC_BATCH = 16
DEC_SEQ = 64
PAST_LEN = 2048

CHUNK = 64
N_MIXERS = 2
N_HGRN = (DEPTH + 1) // 2
N_ATTN = DEPTH // 2

HG_EXPAND = 128
HG_HEADS = D_MODEL // HG_EXPAND
HG_DK = HG_EXPAND
HG_DV = D_MODEL // HG_HEADS
GLA_BLOCK = 16

DA_HEAD_DIM = 64
DA_HEADS = D_MODEL // (2 * DA_HEAD_DIM)
Q_BLOCK = 128

EPS = 1e-6
NEG_INF = -1e30
F32 = jnp.float32

kernel_name = "hgrn2_diffattn_streaming_step"


def rms_norm(x, w):
    x32 = x.astype(F32)
    y = x32 * lax.rsqrt(jnp.mean(x32 * x32, axis=-1, keepdims=True) + EPS)
    return y * w.astype(F32)


def hgrn_lower_bounds(logits):
    p = jax.nn.softmax(logits.astype(F32), axis=0)
    return jnp.cumsum(p, axis=0) - p[0]


def _gla_block(S, blk):
    q, k, v, g = blk
    L = q.shape[1]
    b = jnp.cumsum(g, axis=1)
    causal = jnp.tril(jnp.ones((L, L), dtype=bool))[None, :, :, None, None]
    diff = b[:, :, None] - b[:, None, :]
    decay = jnp.exp(jnp.where(causal, diff, -jnp.inf))
    att = jnp.einsum('bthk,bshk,btshk->bhts', q, k, decay)
    o = (jnp.einsum('bthk,bhkv->bthv', q * jnp.exp(b), S)
         + jnp.einsum('bhts,bshv->bthv', att, v))
    b_last = b[:, -1]
    S_new = (jnp.exp(b_last)[..., None] * S
             + jnp.einsum('bshk,bshv->bhkv', k * jnp.exp(b_last[:, None] - b), v))
    return S_new, o


def gla(q, k, v, g, S0, block_len):
    B, T = q.shape[:2]
    nb = T // block_len

    def to_blocks(a):
        return jnp.moveaxis(a.reshape(B, nb, block_len, *a.shape[2:]), 1, 0)

    S, o = lax.scan(_gla_block, S0, (to_blocks(q), to_blocks(k), to_blocks(v), to_blocks(g)))
    o = jnp.moveaxis(o, 0, 1).reshape(B, T, HG_HEADS, HG_DV)
    return o, S


def hgrn_layer(x, S0, norm_w, w_in, lb, onorm_w, w_out, block_len):
    B, T, _ = x.shape
    h = rms_norm(x, norm_w).astype(x.dtype)
    q, fx, i, z = jnp.split(h @ w_in, 4, axis=-1)
    f = lb + (1.0 - lb) * jax.nn.sigmoid(fx.astype(F32))
    g = jnp.log(f)
    k = 1.0 - f
    shp = (B, T, HG_HEADS, HG_DK)
    q32 = q.astype(F32).reshape(shp) * (HG_DK ** -0.5)
    v32 = i.astype(F32).reshape(B, T, HG_HEADS, HG_DV)
    o, S = gla(q32, k.reshape(shp), v32, g.reshape(shp), S0.astype(F32), block_len)
    o = rms_norm(o.reshape(B, T, D_MODEL), onorm_w).astype(x.dtype) * jax.nn.silu(z)
    return x + o @ w_out, S.astype(x.dtype)


def diff_attend(q, k, v, q_pos, k_pos, slopes, lam):
    s = jnp.einsum('bqmhd,bkmhd->bmhqk', q.astype(F32), k.astype(F32)) * (DA_HEAD_DIM ** -0.5)
    dist = jnp.abs(q_pos[:, None] - k_pos[None, :]).astype(F32)
    visible = (k_pos[None, :] // CHUNK) <= (q_pos[:, None] // CHUNK)
    bias = jnp.where(visible[None], -slopes[:, None, None] * dist[None], NEG_INF)
    p = jax.nn.softmax(s + bias, axis=-1)
    a = p[:, 0] - lam * p[:, 1]
    return jnp.einsum('bhqk,bkhe->bqhe', a, v.astype(F32))


def diff_attn_layer(x, k_past, v_past, q_pos, k_pos, norm_w, w_in, qn_w, kn_w, lam_vec, subln_w,
                    w_out, layer_idx, q_block):
    B, T, _ = x.shape
    h = rms_norm(x, norm_w).astype(x.dtype)
    q, k, v, z = jnp.split(h @ w_in, 4, axis=-1)
    q = rms_norm(q.reshape(B, T, 2, DA_HEADS, DA_HEAD_DIM), qn_w).astype(x.dtype)
    k = rms_norm(k.reshape(B, T, 2, DA_HEADS, DA_HEAD_DIM), kn_w).astype(x.dtype)
    v = v.reshape(B, T, DA_HEADS, 2 * DA_HEAD_DIM)
    if k_past is None:
        k_all, v_all = k, v
    else:
        k_all = jnp.concatenate([k_past.astype(k.dtype), k], axis=1)
        v_all = jnp.concatenate([v_past.astype(v.dtype), v], axis=1)
    lam_init = 0.8 - 0.6 * math.exp(-0.3 * layer_idx)
    lv = lam_vec.astype(F32)
    lam = jnp.exp(jnp.sum(lv[0] * lv[1])) - jnp.exp(jnp.sum(lv[2] * lv[3])) + lam_init
    slopes = jnp.exp2(-8.0 * jnp.arange(1, DA_HEADS + 1, dtype=F32) / DA_HEADS)
    nb = T // q_block
    qb = jnp.moveaxis(q.reshape(B, nb, q_block, 2, DA_HEADS, DA_HEAD_DIM), 1, 0)
    pb = q_pos.reshape(nb, q_block)
    o = lax.map(lambda a: diff_attend(a[0], k_all, v_all, a[1], k_pos, slopes, lam), (qb, pb))
    o = jnp.moveaxis(o, 0, 1).reshape(B, T, DA_HEADS, 2 * DA_HEAD_DIM)
    o = rms_norm(o, subln_w) * (1.0 - lam_init)
    o = o.reshape(B, T, D_MODEL).astype(x.dtype) * jax.nn.silu(z)
    return x + o @ w_out, k, v


def setup_inputs(seed: int = 0) -> dict:
    key = jax.random.key(seed)
    ks = jax.random.split(key, 20)
    D = D_MODEL
    sc = D ** -0.5
    nrm = jax.random.normal
    return {
        "x_prompt": nrm(ks[0], (BATCH, SEQ, D), F32),
        "x_sample": nrm(ks[1], (DEC_BATCH, DEC_SEQ, D), F32),
        "cache_k": nrm(ks[2], (N_ATTN, DEC_BATCH, PAST_LEN, 2, DA_HEADS, DA_HEAD_DIM), F32),
        "cache_v": nrm(ks[3], (N_ATTN, DEC_BATCH, PAST_LEN, DA_HEADS, 2 * DA_HEAD_DIM), F32),
        "state_hgrn": 0.5 * nrm(ks[4], (N_HGRN, DEC_BATCH, HG_HEADS, HG_DK, HG_DV), F32),
        "norm_w": 1.0 + 0.02 * nrm(ks[5], (DEPTH, D), F32),
        "hgrn_w_in": sc * nrm(ks[6], (N_HGRN, D, 4 * D), F32),
        "hgrn_lb_logits": 0.1 * nrm(ks[7], (N_HGRN, D), F32),
        "hgrn_onorm_w": 1.0 + 0.02 * nrm(ks[8], (N_HGRN, D), F32),
        "hgrn_w_out": 0.5 * sc * nrm(ks[9], (N_HGRN, D, D), F32),
        "attn_w_in": sc * nrm(ks[10], (N_ATTN, D, 4 * D), F32),
        "attn_q_norm": 1.0 + 0.02 * nrm(ks[11], (N_ATTN, DA_HEAD_DIM), F32),
        "attn_k_norm": 1.0 + 0.02 * nrm(ks[12], (N_ATTN, DA_HEAD_DIM), F32),
        "attn_lambda": 0.1 * nrm(ks[13], (N_ATTN, 4, DA_HEAD_DIM), F32),
        "attn_subln": 1.0 + 0.02 * nrm(ks[14], (N_ATTN, 2 * DA_HEAD_DIM), F32),
        "attn_w_out": 0.5 * sc * nrm(ks[15], (N_ATTN, D, D), F32),
    }


def reference(x_prompt, x_sample, cache_k, cache_v, state_hgrn, norm_w, hgrn_w_in, hgrn_lb_logits,
              hgrn_onorm_w, hgrn_w_out, attn_w_in, attn_q_norm, attn_k_norm, attn_lambda, attn_subln,
              attn_w_out):
    yp, ys = x_prompt, x_sample
    Bp, Tp = yp.shape[0], yp.shape[1]
    Ts = ys.shape[1]
    P = cache_k.shape[2]
    pos_p = jnp.arange(Tp, dtype=jnp.int32)
    pos_sq = P + jnp.arange(Ts, dtype=jnp.int32)
    pos_sk = jnp.arange(P + Ts, dtype=jnp.int32)
    lbs = hgrn_lower_bounds(hgrn_lb_logits)
    kp, vp, ks_, vs_, sp, ss = [], [], [], [], [], []
    for l in range(DEPTH):
        j = l // N_MIXERS
        if l % N_MIXERS == 0:
            S0 = jnp.zeros((Bp, HG_HEADS, HG_DK, HG_DV), yp.dtype)
            yp, s_p = hgrn_layer(yp, S0, norm_w[l], hgrn_w_in[j], lbs[j], hgrn_onorm_w[j],
                                 hgrn_w_out[j], GLA_BLOCK)
            ys, s_s = hgrn_layer(ys, state_hgrn[j], norm_w[l], hgrn_w_in[j], lbs[j], hgrn_onorm_w[j],
                                 hgrn_w_out[j], Ts)
            sp.append(s_p)
            ss.append(s_s)
        else:
            yp, k_p, v_p = diff_attn_layer(yp, None, None, pos_p, pos_p, norm_w[l], attn_w_in[j],
                                           attn_q_norm[j], attn_k_norm[j], attn_lambda[j],
                                           attn_subln[j], attn_w_out[j], l, min(Q_BLOCK, Tp))
            ys, k_s, v_s = diff_attn_layer(ys, cache_k[j], cache_v[j], pos_sq, pos_sk, norm_w[l],
                                           attn_w_in[j], attn_q_norm[j], attn_k_norm[j],
                                           attn_lambda[j], attn_subln[j], attn_w_out[j], l, Ts)
            kp.append(k_p)
            vp.append(v_p)
            ks_.append(k_s)
            vs_.append(v_s)
    return (yp, ys, jnp.stack(kp), jnp.stack(vp), jnp.stack(ks_), jnp.stack(vs_), jnp.stack(sp), jnp.stack(ss))
```

```cpp
#include <hip/hip_runtime.h>
#include <hip/hip_cooperative_groups.h>
#include <cstdio>
#include <cstdint>
namespace cg = cooperative_groups;
namespace pg8 {
#define PG8_LAS __attribute__((address_space(3)))
typedef unsigned short bf16_t;
typedef short bf16x8 __attribute__((ext_vector_type(8)));
typedef float f32x4 __attribute__((ext_vector_type(4)));
typedef unsigned u32x4 __attribute__((ext_vector_type(4)));
constexpr int BM = 256, BK = 64, HALF = 128, HTB = HALF * BK * 2  , STAGE_BYTES = 8 * HTB, NXCD = 8, WGM = 8;

__host__ __device__ __forceinline__ int lds_byte(int r, int c) { const int st = (r >> 4) * 2 + (c >> 5), rr = r & 15, cc = c & 31, ob = rr * 64 + cc * 2; return st * 1024 + (ob ^ (((ob >> 9) & 1) << 5)); }
__host__ __device__ __forceinline__ void stage_rc(int b, int& R, int& C) { const int st = b / 1024, sb = b % 1024, swz = sb ^ (((sb >> 9) & 1) << 5); R = (st >> 1) * 16 + swz / 64; C = (st & 1) * 32 + (swz % 64) / 2; }
__host__ __device__ __forceinline__ int perm32(int rho) { const int n = rho >> 4, i = rho & 15; return 8 * (i >> 2) + 4 * n + (i & 3); }

struct Unit { int pm, pn; };
struct Gemm { const bf16_t* A; const bf16_t* Bt; int M, N, K; };

struct StaticOrder {
    int nM, nN, nwg, G, c;
    __host__ __device__ void init(int M, int N, int G_, int c_) { nM = M / BM; nN = N / BM; nwg = nM * nN; G = G_; c = c_; }
    __host__ __device__ bool next(int i, Unit& u) const {
        const long L = (long)i * G + c; if (L >= nwg) return false;
        int wgid = (int)L; { const int q = nwg / NXCD, r = nwg % NXCD, xcd = wgid % NXCD, off = wgid / NXCD; wgid = (xcd < r ? xcd * (q + 1) : r * (q + 1) + (xcd - r) * q) + off; }
        const int nig = WGM * nN, gid = wgid / nig, fm = gid * WGM, gsz = (nM - fm) < WGM ? (nM - fm) : WGM;
        u.pm = fm + ((wgid % nig) % gsz); u.pn = (wgid % nig) / gsz; return true;
    }
    __device__ __forceinline__ void a_ready(const Unit&) const {}
    __device__ __forceinline__ void done(const Unit&) const {}
};
__device__ __forceinline__ unsigned cvt_pk_bf16(float lo, float hi) { unsigned r; asm volatile("v_cvt_pk_bf16_f32 %0, %1, %2" : "=v"(r) : "v"(lo), "v"(hi)); return r; }
template <class Epi, class Sched, bool STAMP = false>
__device__ __forceinline__ void gemm_phase(PG8_LAS unsigned char* lds, const Gemm g, const Sched& S, const Epi& E, unsigned long long* stamps) {
    int tid_l = threadIdx.x; asm volatile("" : "+v"(tid_l));
    const int tid = tid_l, wid = __builtin_amdgcn_readfirstlane(tid >> 6), lane = tid & 63, wr = wid >> 2, wc = wid & 3, fr = lane & 15, fq = lane >> 4;
    const int K = g.K, nt = K / BK;
    int ts_lo = 0, ts_hi = 0, nts = 0; const unsigned long long rt_entry = STAMP ? (unsigned long long)wall_clock64() : 0ull;
#define PG8_STAMP() do { if (STAMP && wid == 0 && nts < 64) { const unsigned long long _c = (unsigned long long)clock64(); \
        ts_lo = (lane == nts) ? (int)(unsigned)_c : ts_lo; ts_hi = (lane == nts) ? (int)(unsigned)(_c >> 32) : ts_hi; ++nts; } } while (0)
    PG8_STAMP();
    unsigned voffA[2], voffB[2];
#pragma unroll
    for (int i = 0; i < 2; ++i) { int R, C; stage_rc(tid * 16 + i * 8192, R, C); const int Rb = Epi::PERM ? ((R & ~31) + perm32(R & 31)) : R;
        voffA[i] = (unsigned)(R * K + C) * 2u; voffB[i] = (unsigned)(Rb * K + C) * 2u; }
    const size_t kstep = (size_t)(BK * 2);
    const size_t hstep = (size_t)HALF * K * 2;
    const size_t tstep = 2 * hstep;
    const unsigned ldsw = (unsigned)wid * 1024u;
    const int aoff = lds_byte(wr * 64 + fr, fq * 8), boff = lds_byte(wc * 32 + fr, fq * 8);
#define PG8_SA(b, h) (((b) * 2 + (h)) * HTB)
#define PG8_SB(b, h) ((4 + (b) * 2 + (h)) * HTB)
#define PG8_STAGE(bufoff, gbase, voff) do { _Pragma("unroll") for (int _i = 0; _i < 2; ++_i) \
        __builtin_amdgcn_global_load_lds((const unsigned*)((const char*)(gbase) + (voff)[_i]), (PG8_LAS unsigned*)(lds + (bufoff) + ldsw + _i * 8192), 16, 0, 0); } while (0)
#define PG8_LDA(dst, b, h) do { _Pragma("unroll") for (int m = 0; m < 4; ++m) _Pragma("unroll") for (int k = 0; k < 2; ++k) dst[m][k] = *(const PG8_LAS bf16x8*)(lds + PG8_SA(b, h) + aoff + m * 2048 + k * 1024); } while (0)
#define PG8_LDB(dst, b, h) do { _Pragma("unroll") for (int n = 0; n < 2; ++n) _Pragma("unroll") for (int k = 0; k < 2; ++k) dst[n][k] = *(const PG8_LAS bf16x8*)(lds + PG8_SB(b, h) + boff + n * 2048 + k * 1024); } while (0)
#define PG8_MMA(ai, bj, At, Bt) do { __builtin_amdgcn_s_setprio(1); _Pragma("unroll") for (int m = 0; m < 4; ++m) _Pragma("unroll") for (int n = 0; n < 2; ++n) _Pragma("unroll") for (int k = 0; k < 2; ++k) \
        acc[ai][bj][m][n] = __builtin_amdgcn_mfma_f32_16x16x32_bf16(Bt[n][k], At[m][k], acc[ai][bj][m][n], 0, 0, 0); __builtin_amdgcn_s_setprio(0); } while (0)
#define PG8_WAIT_V(n) asm volatile("s_waitcnt vmcnt(" #n ")" ::: "memory")
#define PG8_WAIT_L(n) asm volatile("s_waitcnt lgkmcnt(" #n ")" ::: "memory")
#define PG8_BAR __builtin_amdgcn_s_barrier()
#define PG8_SCHED __builtin_amdgcn_sched_barrier(0)
    Unit cur, nxt; int ui = 0;
    if (!S.next(0, cur)) return;
    f32x4 acc[2][2][4][2];
#pragma unroll
    for (int a = 0; a < 2; ++a)
#pragma unroll
        for (int b = 0; b < 2; ++b)
#pragma unroll
            for (int m = 0; m < 4; ++m)
#pragma unroll
                for (int n = 0; n < 2; ++n) acc[a][b][m][n] = (f32x4){0.f, 0.f, 0.f, 0.f};
    bf16x8 At[4][2], B0[2][2], B1[2][2];
    const char* cA = (const char*)g.A + (size_t)cur.pm * tstep; const char* cB = (const char*)g.Bt + (size_t)cur.pn * tstep;
    S.a_ready(cur);
    PG8_STAGE(PG8_SB(0, 0), cB, voffB); PG8_STAGE(PG8_SA(0, 0), cA, voffA); PG8_STAGE(PG8_SB(0, 1), cB + hstep, voffB); PG8_STAGE(PG8_SA(0, 1), cA + hstep, voffA);
    if (wr == 1) PG8_BAR;
    PG8_WAIT_V(4); PG8_BAR;
    PG8_STAGE(PG8_SB(1, 0), cB + kstep, voffB); PG8_STAGE(PG8_SA(1, 0), cA + kstep, voffA); PG8_STAGE(PG8_SB(1, 1), cB + hstep + kstep, voffB);
    PG8_WAIT_V(6); PG8_BAR;
    PG8_STAMP();
    for (;;) {
        const bool has_next = S.next(ui + 1, nxt);
        const char* nA = has_next ? (const char*)g.A + (size_t)nxt.pm * tstep : cA; const char* nB = has_next ? (const char*)g.Bt + (size_t)nxt.pn * tstep : cB;
        for (int t = 0; t < nt; t += 2) {
            const bool last = (t == nt - 2);
            const char* a1 = cA + (size_t)(t + 1) * kstep;
            const char* a2 = last ? nA : cA + (size_t)(t + 2) * kstep; const char* b2 = last ? nB : cB + (size_t)(t + 2) * kstep;
            const char* a3 = a2 + kstep; const char* b3 = b2 + kstep;
            if (last && has_next) S.a_ready(nxt);
            PG8_LDB(B0, 0, 0); PG8_SCHED; PG8_LDA(At, 0, 0); PG8_STAGE(PG8_SA(1, 1), a1 + hstep, voffA);
            PG8_WAIT_L(8); PG8_BAR; PG8_WAIT_L(0); PG8_MMA(0, 0, At, B0); PG8_BAR; PG8_SCHED;
            PG8_LDB(B1, 0, 1); PG8_STAGE(PG8_SB(0, 0), b2, voffB);
            PG8_BAR; PG8_WAIT_L(0); PG8_MMA(0, 1, At, B1); PG8_BAR;
            PG8_LDA(At, 0, 1); PG8_STAGE(PG8_SA(0, 0), a2, voffA);
            PG8_BAR; PG8_WAIT_L(0); PG8_MMA(1, 0, At, B0); PG8_BAR; PG8_SCHED;
            PG8_STAGE(PG8_SB(0, 1), b2 + hstep, voffB);
            PG8_WAIT_V(6); PG8_BAR; PG8_MMA(1, 1, At, B1); PG8_BAR;
            PG8_LDB(B0, 1, 0); PG8_SCHED; PG8_LDA(At, 1, 0); PG8_STAGE(PG8_SA(0, 1), a2 + hstep, voffA);
            PG8_WAIT_L(8); PG8_BAR; PG8_WAIT_L(0); PG8_MMA(0, 0, At, B0); PG8_BAR; PG8_SCHED;
            PG8_LDB(B1, 1, 1); PG8_STAGE(PG8_SB(1, 0), b3, voffB);
            PG8_BAR; PG8_WAIT_L(0); PG8_MMA(0, 1, At, B1); PG8_BAR;
            PG8_LDA(At, 1, 1); PG8_STAGE(PG8_SA(1, 0), a3, voffA);
            PG8_BAR; PG8_WAIT_L(0); PG8_MMA(1, 0, At, B0); PG8_BAR; PG8_SCHED;
            PG8_STAGE(PG8_SB(1, 1), b3 + hstep, voffB);
            PG8_WAIT_V(6); PG8_BAR; PG8_MMA(1, 1, At, B1); PG8_BAR;
        }
        PG8_STAMP();
        if constexpr (!Epi::AFTER_DRAIN) { E(acc, cur, wr, wc, fr, fq); S.done(cur); }
        PG8_STAMP();
        if (!has_next) break;
#pragma unroll
        for (int a = 0; a < 2; ++a)
#pragma unroll
            for (int b = 0; b < 2; ++b)
#pragma unroll
                for (int m = 0; m < 4; ++m)
#pragma unroll
                    for (int n = 0; n < 2; ++n) acc[a][b][m][n] = (f32x4){0.f, 0.f, 0.f, 0.f};
        cur = nxt; cA = nA; cB = nB; ++ui;
    }
    PG8_WAIT_V(0);
    if (wr == 0) PG8_BAR;
    PG8_BAR;
    if constexpr (Epi::AFTER_DRAIN) { E.fused(acc, cur, wr, wc, fr, fq, lds, wid, lane); S.done(cur); }
    PG8_STAMP();
    if (STAMP && wid == 0) { stamps[lane] = lane < nts ? (((unsigned long long)(unsigned)ts_hi << 32) | (unsigned)ts_lo) : 0ull;
        if (lane == 62) stamps[62] = rt_entry; if (lane == 63) stamps[63] = (unsigned long long)wall_clock64(); }
#undef PG8_STAMP
#undef PG8_SA
#undef PG8_SB
#undef PG8_STAGE
#undef PG8_LDA
#undef PG8_LDB
#undef PG8_MMA
#undef PG8_WAIT_V
#undef PG8_WAIT_L
#undef PG8_BAR
#undef PG8_SCHED
}
}

#define LAS __attribute__((address_space(3)))
using pg8::bf16_t; using pg8::bf16x8; using pg8::f32x4; using pg8::u32x4;
typedef short bf16x4 __attribute__((ext_vector_type(4)));
typedef float f32x16 __attribute__((ext_vector_type(16)));
typedef unsigned u32x2 __attribute__((ext_vector_type(2)));
typedef short v4i16_t __attribute__((ext_vector_type(4)));

constexpr int DM = 1024, MP = 65536, MS = 1024, MT = MP + MS, KVS = 2112;
constexpr float EPS = 1e-6f, LOG2E = 1.4426950408889634f;
constexpr size_t O_YP = 0, O_YS = 67108864, O_KP = 68157440, O_VP = 202375168, O_KS = 336592896, O_VS = 338690048, O_SP = 340787200, O_SS = 349175808;
constexpr size_t MiB = 1u << 20;
constexpr size_t WS_WTIN = 0, WS_WTOUT = 32 * MiB, WS_LB = 40 * MiB, WS_SSQ = 41 * MiB, WS_OSSQ = 46 * MiB, WS_XA = 64 * MiB, WS_QB = 200 * MiB, WS_KB = 336 * MiB,
                 WS_VB = 472 * MiB, WS_ZB = 608 * MiB, WS_AO = 744 * MiB, WS_KC = 880 * MiB, WS_VC = 1016 * MiB, WS_END = 1152 * MiB;
constexpr int LDS_BYTES = 147456;

struct Params {
    const float *x_prompt, *x_sample, *cache_k, *cache_v, *state_hgrn, *norm_w, *hgrn_w_in, *hgrn_lb_logits, *hgrn_onorm_w, *hgrn_w_out,
                *attn_w_in, *attn_q_norm, *attn_k_norm, *attn_lambda, *attn_subln, *attn_w_out;
    float* out; unsigned char* ws;
};

__device__ __forceinline__ unsigned pk2(float lo, float hi) { typedef float f2 __attribute__((ext_vector_type(2))); typedef __bf16 b2 __attribute__((ext_vector_type(2)));
    f2 v = {lo, hi}; b2 b = __builtin_convertvector(v, b2); return __builtin_bit_cast(unsigned, b); }
__device__ __forceinline__ float bflo(unsigned u) { return __uint_as_float(u << 16); }
__device__ __forceinline__ float bfhi(unsigned u) { return __uint_as_float(u & 0xffff0000u); }
__device__ __forceinline__ float wave_sum(float v) {
#pragma unroll
    for (int o = 32; o > 0; o >>= 1) v += __shfl_xor(v, o);
    return v; }
__device__ __forceinline__ float ex2(float x) { return __builtin_amdgcn_exp2f(x); }
__device__ __forceinline__ u32x4 pack8(f32x4 a, f32x4 b) { u32x4 r; r[0] = pk2(a[0], a[1]); r[1] = pk2(a[2], a[3]); r[2] = pk2(b[0], b[1]); r[3] = pk2(b[2], b[3]); return r; }

struct EpiIn {
    static constexpr bool PERM = true, AFTER_DRAIN = false;
    int mode;
    const float* ssq;
    const float* lb;
    const float* qn; const float* kn;
    bf16_t *QB, *KB, *VB, *ZB;
    bf16_t *KC, *VC;
    float *okp, *ovp, *oks, *ovs;
    __device__ __forceinline__ void operator()(const f32x4 (&acc)[2][2][4][2], const pg8::Unit& u, int wr, int wc, int fr, int fq) const {
        const int region = u.pn >> 2, pg = u.pn & 3;
        const int cb = pg * 256 + wc * 64 + 8 * fq;
        const bool samp = u.pm >= 256;
#pragma unroll
        for (int ai = 0; ai < 2; ++ai)
#pragma unroll
            for (int m = 0; m < 4; ++m) {
                const int row = u.pm * 256 + ai * 128 + wr * 64 + m * 16 + fr;
                const f32x4* sp = (const f32x4*)(ssq + (size_t)row * 16);
                const f32x4 sa = sp[0] + sp[1] + sp[2] + sp[3];
                const float rs = rsqrtf((sa[0] + sa[1] + sa[2] + sa[3]) * (1.f / 1024.f) + EPS);
                f32x4 v[2][2];
#pragma unroll
                for (int bj = 0; bj < 2; ++bj)
#pragma unroll
                    for (int n = 0; n < 2; ++n) v[bj][n] = acc[ai][bj][m][n] * rs;
                if (region == 3) {
#pragma unroll
                    for (int bj = 0; bj < 2; ++bj) {
#pragma unroll
                        for (int n = 0; n < 2; ++n)
#pragma unroll
                            for (int j = 0; j < 4; ++j) { const float x = v[bj][n][j]; v[bj][n][j] = x / (1.f + __expf(-x)); }
                        *(u32x4*)(ZB + (size_t)row * 1024 + cb + 32 * bj) = pack8(v[bj][0], v[bj][1]);
                    }
                } else if (mode == 0) {
                    if (region == 0) {
#pragma unroll
                        for (int bj = 0; bj < 2; ++bj) *(u32x4*)(QB + (size_t)row * 1024 + cb + 32 * bj) = pack8(v[bj][0] * 0.08838834764831845f, v[bj][1] * 0.08838834764831845f);
                    } else if (region == 1) {
#pragma unroll
                        for (int bj = 0; bj < 2; ++bj) {
#pragma unroll
                            for (int n = 0; n < 2; ++n) { const f32x4 l4 = *(const f32x4*)(lb + cb + 32 * bj + 4 * n);
#pragma unroll
                                for (int j = 0; j < 4; ++j) { const float sg = 1.f / (1.f + __expf(-v[bj][n][j])); const float f = l4[j] + (1.f - l4[j]) * sg; v[bj][n][j] = __log2f(f); } }
                            *(u32x4*)(KB + (size_t)row * 1024 + cb + 32 * bj) = pack8(v[bj][0], v[bj][1]);
                        }
                    } else {
#pragma unroll
                        for (int bj = 0; bj < 2; ++bj) *(u32x4*)(VB + (size_t)row * 1024 + cb + 32 * bj) = pack8(v[bj][0], v[bj][1]);
                    }
                } else {
                    const int srow = row - MP;
                    const size_t crow = samp ? (size_t)(srow >> 6) * KVS + 2048 + (srow & 63) : 0;
                    if (region <= 1) {
                        float ss = 0.f;
#pragma unroll
                        for (int bj = 0; bj < 2; ++bj)
#pragma unroll
                            for (int n = 0; n < 2; ++n)
#pragma unroll
                                for (int j = 0; j < 4; ++j) ss += v[bj][n][j] * v[bj][n][j];
                        ss += __shfl_xor(ss, 16); ss += __shfl_xor(ss, 32);
                        float r2 = rsqrtf(ss * (1.f / 64.f) + EPS);
                        const float* wv = region == 0 ? qn : kn;
                        if (region == 0) r2 *= 0.125f * LOG2E;
#pragma unroll
                        for (int bj = 0; bj < 2; ++bj)
#pragma unroll
                            for (int n = 0; n < 2; ++n) { const f32x4 w4 = *(const f32x4*)(wv + 32 * bj + 8 * fq + 4 * n); v[bj][n] = v[bj][n] * w4 * r2; }
                        if (region == 0) {
#pragma unroll
                            for (int bj = 0; bj < 2; ++bj) *(u32x4*)(QB + (size_t)row * 1024 + cb + 32 * bj) = pack8(v[bj][0], v[bj][1]);
                        } else {
                            float* of = samp ? oks + (size_t)srow * 1024 : okp + (size_t)row * 1024;
                            bf16_t* ob = samp ? KC + crow * 1024 : KB + (size_t)row * 1024;
#pragma unroll
                            for (int bj = 0; bj < 2; ++bj) { *(f32x4*)(of + cb + 32 * bj) = v[bj][0]; *(f32x4*)(of + cb + 32 * bj + 4) = v[bj][1]; *(u32x4*)(ob + cb + 32 * bj) = pack8(v[bj][0], v[bj][1]); }
                        }
                    } else {
                        float* of = samp ? ovs + (size_t)srow * 1024 : ovp + (size_t)row * 1024;
                        bf16_t* ob = samp ? VC + crow * 1024 : VB + (size_t)row * 1024;
#pragma unroll
                        for (int bj = 0; bj < 2; ++bj) { *(f32x4*)(of + cb + 32 * bj) = v[bj][0]; *(f32x4*)(of + cb + 32 * bj + 4) = v[bj][1]; *(u32x4*)(ob + cb + 32 * bj) = pack8(v[bj][0], v[bj][1]); }
                    }
                }
            }
    }
};

struct EpiOut {
    static constexpr bool PERM = true, AFTER_DRAIN = false;
    const float* xp; const float* xs;
    float* out;
    bf16_t* XA;
    float* ssq;
    const float* ossq;
    __device__ __forceinline__ void operator()(const f32x4 (&acc)[2][2][4][2], const pg8::Unit& u, int wr, int wc, int fr, int fq) const {
        const int cb = u.pn * 256 + wc * 32 + 8 * fq;
#pragma unroll
        for (int ai = 0; ai < 2; ++ai)
#pragma unroll
            for (int m = 0; m < 4; ++m) {
                const int row = u.pm * 256 + ai * 128 + wr * 64 + m * 16 + fr;
                const float* xr = row < MP ? xp + (size_t)row * 1024 : xs + (size_t)(row - MP) * 1024;
                float rs = 1.f;
                if (ossq) { const f32x4* op = (const f32x4*)(ossq + (size_t)row * 8); const f32x4 s = op[0] + op[1]; rs = rsqrtf((s[0] + s[1] + s[2] + s[3]) * (1.f / 1024.f) + EPS); }
                float part = 0.f;
#pragma unroll
                for (int bj = 0; bj < 2; ++bj) {
                    const int c = cb + 128 * bj;
                    const f32x4 y0 = *(const f32x4*)(xr + c) + acc[ai][bj][m][0] * rs, y1 = *(const f32x4*)(xr + c + 4) + acc[ai][bj][m][1] * rs;
                    *(f32x4*)(out + (size_t)row * 1024 + c) = y0; *(f32x4*)(out + (size_t)row * 1024 + c + 4) = y1;
                    *(u32x4*)(XA + (size_t)row * 1024 + c) = pack8(y0, y1);
#pragma unroll
                    for (int j = 0; j < 4; ++j) part += y0[j] * y0[j] + y1[j] * y1[j];
                }
                part += __shfl_xor(part, 16); part += __shfl_xor(part, 32);
                if (fq == 0) ssq[(size_t)row * 16 + u.pn * 4 + wc] = part;
            }
    }
};

__device__ __forceinline__ void prologue(const Params& p, LAS unsigned char* lds) {
    int tid = threadIdx.x; asm volatile("" : "+v"(tid));
    const int G = gridDim.x, bx = blockIdx.x, wave = tid >> 6, lane = tid & 63;
    LAS float* ts = (LAS float*)lds;
    bf16_t* wtin = (bf16_t*)(p.ws + WS_WTIN); bf16_t* wtout = (bf16_t*)(p.ws + WS_WTOUT);
    for (int tile = bx; tile < 5120; tile += G) {
        const float* W; bf16_t* WT; int N, ntile, ktile; const float* nw = nullptr; bool perm;
        if (tile < 4096) { const int l = tile >> 10, t = tile & 1023; ntile = t >> 3; ktile = t & 7; N = 4096; perm = true;
            W = ((l & 1) ? p.attn_w_in : p.hgrn_w_in) + (size_t)(l >> 1) * 1024 * 4096; WT = wtin + (size_t)l * 4096 * 1024; nw = p.norm_w + l * 1024; }
        else { const int t2 = tile - 4096, l = t2 >> 8, t = t2 & 255; ntile = t >> 3; ktile = t & 7; N = 1024; perm = false;
            W = ((l & 1) ? p.attn_w_out : p.hgrn_w_out) + (size_t)(l >> 1) * 1024 * 1024; WT = wtout + (size_t)l * 1024 * 1024; }
        const int vcol0 = ntile * 32, k0 = ktile * 128;
        int real0 = vcol0;
        if (perm) { const int region = vcol0 >> 10, rv = vcol0 & 1023, pg = rv >> 8, rem = rv & 255, bj = rem >> 7, wc = (rem & 127) >> 5; real0 = region * 1024 + pg * 256 + wc * 64 + bj * 32; }
#pragma unroll
        for (int i = 0; i < 2; ++i) { const int k = (tid >> 3) + 64 * i, c4 = (tid & 7) * 4;
            const f32x4 v = *(const f32x4*)(W + (size_t)(k0 + k) * N + real0 + c4); const float s = nw ? nw[k0 + k] : 1.f;
#pragma unroll
            for (int e = 0; e < 4; ++e) ts[k * 33 + c4 + e] = v[e] * s; }
        __syncthreads();
        { const int n = tid >> 4, ks = (tid & 15) * 8; f32x4 a, b;
#pragma unroll
            for (int e = 0; e < 4; ++e) { a[e] = ts[(ks + e) * 33 + n]; b[e] = ts[(ks + 4 + e) * 33 + n]; }
            *(u32x4*)(WT + (size_t)(vcol0 + n) * 1024 + k0 + ks) = pack8(a, b); }
        __syncthreads();
    }
    bf16_t* XA = (bf16_t*)(p.ws + WS_XA); float* SSQ = (float*)(p.ws + WS_SSQ);
    for (int row = bx * 8 + wave; row < MT; row += G * 8) {
        const float* xr = row < MP ? p.x_prompt + (size_t)row * 1024 : p.x_sample + (size_t)(row - MP) * 1024;
        float ss = 0.f;
#pragma unroll
        for (int i = 0; i < 4; ++i) { const f32x4 v = *(const f32x4*)(xr + (lane + 64 * i) * 4); ss += v[0] * v[0] + v[1] * v[1] + v[2] * v[2] + v[3] * v[3];
            u32x2 o; o[0] = pk2(v[0], v[1]); o[1] = pk2(v[2], v[3]); *(u32x2*)(XA + (size_t)row * 1024 + (lane + 64 * i) * 4) = o; }
        ss = wave_sum(ss);
        if (lane < 16) SSQ[(size_t)row * 16 + lane] = lane == 0 ? ss : 0.f;
    }
    { bf16_t* KC = (bf16_t*)(p.ws + WS_KC); bf16_t* VC = (bf16_t*)(p.ws + WS_VC);
      const size_t n8 = (size_t)2 * 16 * 2048 * 1024 / 8;
      for (size_t i = (size_t)bx * 512 + tid; i < 2 * n8; i += (size_t)G * 512) {
          const bool wh = i >= n8; const size_t e = (wh ? i - n8 : i) * 8; const size_t jb = e >> 21, rem = e & ((1u << 21) - 1);
          const float* src = (wh ? p.cache_v : p.cache_k) + e; bf16_t* dst = (wh ? VC : KC) + jb * ((size_t)KVS * 1024) + rem;
          *(u32x4*)dst = pack8(((const f32x4*)src)[0], ((const f32x4*)src)[1]); } }
    if (bx == 0) { float* LB = (float*)(p.ws + WS_LB);
        for (int c = tid; c < 1024; c += 512) { const float l0 = p.hgrn_lb_logits[c], l1 = p.hgrn_lb_logits[1024 + c]; LB[c] = 0.f; LB[1024 + c] = 1.f / (1.f + expf(l0 - l1)); } }
}

__device__ __forceinline__ f32x4 mfma16(bf16x4 a, bf16x4 b, f32x4 c) { return __builtin_amdgcn_mfma_f32_16x16x16bf16_1k(a, b, c, 0, 0, 0); }
__device__ __forceinline__ bf16x4 pack4(f32x4 a) { u32x2 r; r[0] = pk2(a[0], a[1]); r[1] = pk2(a[2], a[3]); return __builtin_bit_cast(bf16x4, r); }

__device__ __forceinline__ void gla_phase(const Params& p, LAS unsigned char* lds, int j) {
    int tid = threadIdx.x; asm volatile("" : "+v"(tid));
    const int lane = tid & 63, wave = __builtin_amdgcn_readfirstlane(tid >> 6), G = gridDim.x;
    LAS unsigned char* QH = lds; LAS unsigned char* KH = lds + 17408; LAS unsigned char* KT = lds + 34816; LAS unsigned char* VS = lds + 55296;
    LAS float* OB = (LAS float*)(lds + 72704); LAS float* DL = (LAS float*)(lds + 106496);
    const bf16_t* QB = (const bf16_t*)(p.ws + WS_QB); const bf16_t* GB = (const bf16_t*)(p.ws + WS_KB); const bf16_t* VB = (const bf16_t*)(p.ws + WS_VB); const bf16_t* ZB = (const bf16_t*)(p.ws + WS_ZB);
    bf16_t* AO = (bf16_t*)(p.ws + WS_AO); float* OSSQ = (float*)(p.ws + WS_OSSQ);
    for (int item = blockIdx.x; item < 384; item += G) {
        int lane_l = lane; asm volatile("" : "+v"(lane_l));
        const int v = lane_l & 15, kq = lane_l >> 4;
        const int tv = (wave - 4) * 64 + lane_l;
        int b, h, T; size_t row0; const float* S0; float* Sout;
        if (item < 256) { b = item >> 3; h = item & 7; T = 2048; row0 = (size_t)b * 2048; S0 = nullptr; Sout = p.out + O_SP + ((size_t)(j * 32 + b) * 8 + h) * 16384; }
        else { const int it = item - 256; b = it >> 3; h = it & 7; T = 64; row0 = (size_t)MP + b * 64; S0 = p.state_hgrn + ((size_t)(j * 16 + b) * 8 + h) * 16384; Sout = p.out + O_SS + ((size_t)(j * 16 + b) * 8 + h) * 16384; }
        f32x4 S[8];
#pragma unroll
        for (int i = 0; i < 8; ++i) S[i] = (f32x4){0.f, 0.f, 0.f, 0.f};
        if (S0) {
            const float* sp = S0 + (4 * kq) * 128 + 16 * wave + v;
#pragma unroll
            for (int i = 0; i < 8; ++i)
#pragma unroll
                for (int jj = 0; jj < 4; ++jj) S[i][jj] = sp[(16 * i + jj) * 128];
        }
        const int nsteps = T >> 6;
        unsigned rq[16], rg[16]; u32x4 rv[4], rz[4]; f32x4 ow0, ow1;
        const size_t hb = (size_t)h * 128;
        if (wave < 4) {
#pragma unroll
            for (int t = 0; t < 16; ++t) { const size_t r = row0 + wave * 16 + t; rq[t] = *(const unsigned*)(QB + r * 1024 + hb + 2 * lane); rg[t] = *(const unsigned*)(GB + r * 1024 + hb + 2 * lane); }
        } else {
#pragma unroll
            for (int i = 0; i < 4; ++i) { const int idx = tv + 256 * i; rv[i] = *(const u32x4*)(VB + (row0 + (idx >> 4)) * 1024 + hb + (idx & 15) * 8); }
            ow0 = *(const f32x4*)(p.hgrn_onorm_w + j * 1024 + hb + (tv & 15) * 8); ow1 = *(const f32x4*)(p.hgrn_onorm_w + j * 1024 + hb + (tv & 15) * 8 + 4);
        }
        for (int s = 0; s <= nsteps; ++s) {
            if (wave < 4) {
                if (s < nsteps) {
                    float b0 = 0.f, b1 = 0.f;
#pragma unroll
                    for (int t = 0; t < 16; ++t) {
                        const unsigned q2 = rq[t], g2 = rg[t];
                        const float ga = bflo(g2), gb = bfhi(g2);
                        b0 += ga; b1 += gb;
                        const float qa = bflo(q2) * ex2(b0), qb = bfhi(q2) * ex2(b1);
                        const float ka = (1.f - ex2(ga)) * ex2(fminf(-b0, 120.f)), kb = (1.f - ex2(gb)) * ex2(fminf(-b1, 120.f));
                        const int row = wave * 16 + t;
                        *(LAS unsigned*)(QH + row * 272 + lane * 4) = pk2(qa, qb);
                        const unsigned kk = pk2(ka, kb);
                        *(LAS unsigned*)(KH + row * 272 + lane * 4) = kk;
                        *(LAS unsigned short*)(KT + (wave * 128 + 2 * lane) * 40 + t * 2) = (unsigned short)(kk & 0xffffu);
                        *(LAS unsigned short*)(KT + (wave * 128 + 2 * lane + 1) * 40 + t * 2) = (unsigned short)(kk >> 16);
                    }
                    DL[wave * 128 + 2 * lane] = ex2(b0); DL[wave * 128 + 2 * lane + 1] = ex2(b1);
                    if (s + 1 < nsteps) {
#pragma unroll
                        for (int t = 0; t < 16; ++t) { const size_t r = row0 + (s + 1) * 64 + wave * 16 + t; rq[t] = *(const unsigned*)(QB + r * 1024 + hb + 2 * lane); rg[t] = *(const unsigned*)(GB + r * 1024 + hb + 2 * lane); }
                    }
                }
            } else {
                if (s > 0) {
#pragma unroll
                    for (int i = 0; i < 4; ++i) { const int idx = tv + 256 * i, r = idx >> 4, sg = idx & 15;
                        const f32x4 o0 = *(LAS f32x4*)(OB + r * 132 + sg * 8), o1 = *(LAS f32x4*)(OB + r * 132 + sg * 8 + 4);
                        const u32x4 z = rz[i];
                        f32x4 a0, a1;
                        a0[0] = o0[0] * ow0[0] * bflo(z[0]); a0[1] = o0[1] * ow0[1] * bfhi(z[0]); a0[2] = o0[2] * ow0[2] * bflo(z[1]); a0[3] = o0[3] * ow0[3] * bfhi(z[1]);
                        a1[0] = o1[0] * ow1[0] * bflo(z[2]); a1[1] = o1[1] * ow1[1] * bfhi(z[2]); a1[2] = o1[2] * ow1[2] * bflo(z[3]); a1[3] = o1[3] * ow1[3] * bfhi(z[3]);
                        const size_t grow = row0 + (size_t)(s - 1) * 64 + r;
                        *(u32x4*)(AO + grow * 1024 + hb + sg * 8) = pack8(a0, a1);
                        float ss = o0[0] * o0[0] + o0[1] * o0[1] + o0[2] * o0[2] + o0[3] * o0[3] + o1[0] * o1[0] + o1[1] * o1[1] + o1[2] * o1[2] + o1[3] * o1[3];
                        ss += __shfl_xor(ss, 1); ss += __shfl_xor(ss, 2); ss += __shfl_xor(ss, 4); ss += __shfl_xor(ss, 8);
                        if (sg == 0) OSSQ[grow * 8 + h] = ss; }
                }
                if (s < nsteps) {
#pragma unroll
                    for (int i = 0; i < 4; ++i) { const int idx = tv + 256 * i; *(LAS u32x4*)(VS + (idx >> 4) * 272 + (idx & 15) * 16) = rv[i]; }
#pragma unroll
                    for (int i = 0; i < 4; ++i) { const int idx = tv + 256 * i; rz[i] = *(const u32x4*)(ZB + (row0 + (size_t)s * 64 + (idx >> 4)) * 1024 + hb + (idx & 15) * 8); }
                    if (s + 1 < nsteps) {
#pragma unroll
                        for (int i = 0; i < 4; ++i) { const int idx = tv + 256 * i; rv[i] = *(const u32x4*)(VB + (row0 + (size_t)(s + 1) * 64 + (idx >> 4)) * 1024 + hb + (idx & 15) * 8); }
                    }
                }
            }
            __syncthreads();
            if (s == nsteps) break;
#pragma unroll 1
            for (int c = 0; c < 4; ++c) {
                bf16x4 qf[8], kf[8];
#pragma unroll
                for (int i = 0; i < 8; ++i) { qf[i] = *(LAS bf16x4*)(QH + (c * 16 + v) * 272 + (16 * i + 4 * kq) * 2); kf[i] = *(LAS bf16x4*)(KH + (c * 16 + v) * 272 + (16 * i + 4 * kq) * 2); }
                bf16x4 vf;
#pragma unroll
                for (int jj = 0; jj < 4; ++jj) vf[jj] = *(LAS short*)(VS + (c * 16 + 4 * kq + jj) * 272 + (16 * wave + v) * 2);
                f32x4 o0 = {0.f, 0.f, 0.f, 0.f}, o1 = o0, a0 = o0, a1 = o0;
#pragma unroll
                for (int i = 0; i < 8; i += 2) { o0 = mfma16(qf[i], pack4(S[i]), o0); o1 = mfma16(qf[i + 1], pack4(S[i + 1]), o1); a0 = mfma16(kf[i], qf[i], a0); a1 = mfma16(kf[i + 1], qf[i + 1], a1); }
                f32x4 at = a0 + a1;
#pragma unroll
                for (int jj = 0; jj < 4; ++jj) if (4 * kq + jj > v) at[jj] = 0.f;
                f32x4 o = mfma16(pack4(at), vf, o0 + o1);
#pragma unroll
                for (int i = 0; i < 8; ++i) { const bf16x4 ktf = *(LAS bf16x4*)(KT + (c * 128 + 16 * i + v) * 40 + 8 * kq); S[i] = mfma16(ktf, vf, S[i]); }
#pragma unroll
                for (int i = 0; i < 8; ++i) { const f32x4 d = *(LAS f32x4*)(DL + c * 128 + 16 * i + 4 * kq); S[i] = S[i] * d; }
#pragma unroll
                for (int jj = 0; jj < 4; ++jj) OB[(c * 16 + 4 * kq + jj) * 132 + 16 * wave + v] = o[jj];
            }
            __syncthreads();
        }
        { float* so = Sout + (4 * kq) * 128 + 16 * wave + v;
#pragma unroll
        for (int i = 0; i < 8; ++i)
#pragma unroll
            for (int jj = 0; jj < 4; ++jj) so[(16 * i + jj) * 128] = S[i][jj]; }
    }
}

__device__ __forceinline__ f32x16 mfma32(bf16x8 a, bf16x8 b, f32x16 c) { return __builtin_amdgcn_mfma_f32_32x32x16_bf16(a, b, c, 0, 0, 0); }
__device__ __forceinline__ v4i16_t ldtr(const LAS unsigned char* q) { return __builtin_amdgcn_ds_read_tr16_b64_v4i16((LAS v4i16_t*)q); }

__device__ __forceinline__ void attn_unit(LAS unsigned char* lds, const bf16_t* QB, const bf16_t* Kb, const bf16_t* Vb, const bf16_t* ZB, bf16_t* AO, const float* subln,
                                          size_t row0q, int h, int ntiles, int qpos0, int nrg, bool partial, float lam, float osc) {
    int tid = threadIdx.x; asm volatile("" : "+v"(tid));
    const int lane = tid & 63, wave = __builtin_amdgcn_readfirstlane(tid >> 6), rg = wave & 3, mp = wave >> 2, ql = lane & 31, hh = lane >> 5;
    const bool active = rg < nrg;
    const float slope2 = ex2(-(float)(h + 1)) * LOG2E;
    bf16x8 qf[4];
    if (active) {
#pragma unroll
        for (int ks = 0; ks < 4; ++ks) qf[ks] = *(const bf16x8*)(QB + (row0q + rg * 32 + ql) * 1024 + mp * 512 + h * 64 + ks * 16 + hh * 8);
    }
    f32x16 ot[4];
#pragma unroll
    for (int dt = 0; dt < 4; ++dt)
#pragma unroll
        for (int r = 0; r < 16; ++r) ot[dt][r] = 0.f;
    float mrow = -1e30f, lrow = 0.f;
    const float qpos = (float)(qpos0 + rg * 32 + ql);
    u32x4 sr[4];
    const int kkey = tid >> 3, kseg = tid & 7, vkey = tid >> 4, vseg = tid & 15;
#define ATT_LOAD(jt) do { \
        sr[0] = *(const u32x4*)(Kb + ((size_t)(jt) * 64 + kkey) * 1024 + h * 64 + kseg * 8); sr[1] = *(const u32x4*)(Kb + ((size_t)(jt) * 64 + kkey) * 1024 + 512 + h * 64 + kseg * 8); \
        sr[2] = *(const u32x4*)(Vb + ((size_t)(jt) * 64 + vkey) * 1024 + h * 128 + vseg * 8); sr[3] = *(const u32x4*)(Vb + ((size_t)(jt) * 64 + vkey + 32) * 1024 + h * 128 + vseg * 8); } while (0)
#define ATT_STORE(buf) do { LAS unsigned char* _b = lds + (buf) * 35840; \
        *(LAS u32x4*)(_b + kkey * 144 + kseg * 16) = sr[0]; *(LAS u32x4*)(_b + 9216 + kkey * 144 + kseg * 16) = sr[1]; \
        *(LAS u32x4*)(_b + 18432 + vkey * 272 + vseg * 16) = sr[2]; *(LAS u32x4*)(_b + 18432 + (vkey + 32) * 272 + vseg * 16) = sr[3]; } while (0)
    ATT_LOAD(0); ATT_STORE(0);
    __syncthreads();
    for (int jt = 0; jt < ntiles; ++jt) {
        const int buf = jt & 1;
        if (jt + 1 < ntiles) ATT_LOAD(jt + 1);
        const bool doit = active && !(partial && jt == ntiles - 1 && rg < 2);
        if (doit) {
            const LAS unsigned char* Kt = lds + buf * 35840 + mp * 9216; const LAS unsigned char* Vt = lds + buf * 35840 + 18432;
            f32x16 st[2];
#pragma unroll
            for (int kt = 0; kt < 2; ++kt) {
#pragma unroll
                for (int r = 0; r < 16; ++r) st[kt][r] = 0.f;
#pragma unroll
                for (int ks = 0; ks < 4; ++ks) { const bf16x8 kfr = *(LAS bf16x8*)(Kt + (kt * 32 + ql) * 144 + ks * 32 + hh * 16); st[kt] = mfma32(kfr, qf[ks], st[kt]); }
            }
            float mx = mrow;
            const float kb = (float)(jt * 64 + 4 * hh);
#pragma unroll
            for (int kt = 0; kt < 2; ++kt)
#pragma unroll
                for (int r = 0; r < 16; ++r) { const float kpos = kb + (float)(kt * 32 + (r & 3) + 8 * (r >> 2)); const float sv = st[kt][r] - slope2 * fabsf(qpos - kpos); st[kt][r] = sv; mx = fmaxf(mx, sv); }
            mx = fmaxf(mx, __shfl_xor(mx, 32));
            const float alpha = ex2(mrow - mx); mrow = mx;
            float ps = 0.f;
#pragma unroll
            for (int kt = 0; kt < 2; ++kt)
#pragma unroll
                for (int r = 0; r < 16; ++r) { const float pv = ex2(st[kt][r] - mx); st[kt][r] = pv; ps += pv; }
            lrow = lrow * alpha + ps;
#pragma unroll
            for (int dt = 0; dt < 4; ++dt) ot[dt] = ot[dt] * alpha;
#pragma unroll
            for (int sp = 0; sp < 4; ++sp) {
                const int kt = sp >> 1, s8 = (sp & 1) * 8;
                u32x4 pp; pp[0] = pk2(st[kt][s8 + 0], st[kt][s8 + 1]); pp[1] = pk2(st[kt][s8 + 2], st[kt][s8 + 3]); pp[2] = pk2(st[kt][s8 + 4], st[kt][s8 + 5]); pp[3] = pk2(st[kt][s8 + 6], st[kt][s8 + 7]);
                const bf16x8 pf = __builtin_bit_cast(bf16x8, pp);
                const LAS unsigned char* vrow = Vt + (kt * 32 + 2 * s8 + 4 * hh + ((lane >> 2) & 3)) * 272 + (16 * ((lane >> 4) & 1) + 4 * (lane & 3)) * 2;
#pragma unroll
                for (int dt = 0; dt < 4; ++dt) {
                    const v4i16_t lo = ldtr(vrow + dt * 64), hi = ldtr(vrow + dt * 64 + 8 * 272);
                    bf16x8 vfr; vfr[0] = lo[0]; vfr[1] = lo[1]; vfr[2] = lo[2]; vfr[3] = lo[3]; vfr[4] = hi[0]; vfr[5] = hi[1]; vfr[6] = hi[2]; vfr[7] = hi[3];
                    ot[dt] = mfma32(vfr, pf, ot[dt]);
                }
            }
        }
        if (jt + 1 < ntiles) ATT_STORE(buf ^ 1);
        __syncthreads();
    }
#undef ATT_LOAD
#undef ATT_STORE
    const float lt = lrow + __shfl_xor(lrow, 32);
    const float inv = 1.f / lt;
    LAS float* EX = (LAS float*)(lds + 71680) + (rg * 32 + ql) * 132;
    if (active && mp == 1) {
        const float sc = inv * lam;
#pragma unroll
        for (int dt = 0; dt < 4; ++dt)
#pragma unroll
            for (int g4 = 0; g4 < 4; ++g4) { f32x4 e; e[0] = ot[dt][4 * g4] * sc; e[1] = ot[dt][4 * g4 + 1] * sc; e[2] = ot[dt][4 * g4 + 2] * sc; e[3] = ot[dt][4 * g4 + 3] * sc; *(LAS f32x4*)(EX + dt * 32 + 8 * g4 + 4 * hh) = e; }
    }
    __syncthreads();
    if (active && mp == 0) {
        float ss = 0.f;
#pragma unroll
        for (int dt = 0; dt < 4; ++dt)
#pragma unroll
            for (int g4 = 0; g4 < 4; ++g4) { const f32x4 e = *(LAS f32x4*)(EX + dt * 32 + 8 * g4 + 4 * hh);
#pragma unroll
                for (int i = 0; i < 4; ++i) { const float o = ot[dt][4 * g4 + i] * inv - e[i]; ot[dt][4 * g4 + i] = o; ss += o * o; } }
        ss += __shfl_xor(ss, 32);
        const float rs = rsqrtf(ss * (1.f / 128.f) + EPS) * osc;
        const size_t row = row0q + rg * 32 + ql;
#pragma unroll
        for (int dt = 0; dt < 4; ++dt)
#pragma unroll
            for (int g4 = 0; g4 < 4; ++g4) { const int dv = dt * 32 + 8 * g4 + 4 * hh; const f32x4 w = *(const f32x4*)(subln + dv); const u32x2 z = *(const u32x2*)(ZB + row * 1024 + h * 128 + dv);
                u32x2 o; o[0] = pk2(ot[dt][4 * g4] * rs * w[0] * bflo(z[0]), ot[dt][4 * g4 + 1] * rs * w[1] * bfhi(z[0])); o[1] = pk2(ot[dt][4 * g4 + 2] * rs * w[2] * bflo(z[1]), ot[dt][4 * g4 + 3] * rs * w[3] * bfhi(z[1]));
                *(u32x2*)(AO + row * 1024 + h * 128 + dv) = o; }
    }
}

__device__ __forceinline__ void attn_phase(const Params& p, LAS unsigned char* lds, int j, int l) {
    const int lane = threadIdx.x & 63, G = gridDim.x;
    const float* lv = p.attn_lambda + j * 256;
    const float s01 = wave_sum(lv[lane] * lv[64 + lane]), s23 = wave_sum(lv[128 + lane] * lv[192 + lane]);
    const float lam_init = 0.8f - 0.6f * expf(-0.3f * (float)l);
    const float lam = expf(s01) - expf(s23) + lam_init, osc = 1.f - lam_init;
    const bf16_t* QB = (const bf16_t*)(p.ws + WS_QB); const bf16_t* KB = (const bf16_t*)(p.ws + WS_KB); const bf16_t* VB = (const bf16_t*)(p.ws + WS_VB); const bf16_t* ZB = (const bf16_t*)(p.ws + WS_ZB);
    const bf16_t* KC = (const bf16_t*)(p.ws + WS_KC) + (size_t)j * 16 * KVS * 1024; const bf16_t* VC = (const bf16_t*)(p.ws + WS_VC) + (size_t)j * 16 * KVS * 1024;
    bf16_t* AO = (bf16_t*)(p.ws + WS_AO);
    const float* subln = p.attn_subln + j * 128;
    for (int item = blockIdx.x; item < 384; item += G) {
        if (item < 256) { const int b = item >> 3, h = item & 7;
#pragma unroll 1
            for (int qb = 0; qb < 16; ++qb)
                attn_unit(lds, QB, KB + (size_t)b * 2048 * 1024, VB + (size_t)b * 2048 * 1024, ZB, AO, subln, (size_t)b * 2048 + qb * 128, h, 2 * qb + 2, qb * 128, 4, true, lam, osc);
        } else { const int it = item - 256, b = it >> 3, h = it & 7;
            attn_unit(lds, QB, KC + (size_t)b * KVS * 1024, VC + (size_t)b * KVS * 1024, ZB, AO, subln, (size_t)MP + b * 64, h, 33, 2048, 2, false, lam, osc);
        }
    }
}

__global__ void __launch_bounds__(512, 2) mega_fwd(Params p) {
    extern __shared__ __attribute__((aligned(16))) unsigned char lds_raw[];
    LAS unsigned char* lds = (LAS unsigned char*)lds_raw;
    cg::grid_group grid = cg::this_grid();
    prologue(p, lds);
    grid.sync();
    bf16_t* XA = (bf16_t*)(p.ws + WS_XA); bf16_t* AO = (bf16_t*)(p.ws + WS_AO);
    float* SSQ = (float*)(p.ws + WS_SSQ); float* OSSQ = (float*)(p.ws + WS_OSSQ);
#pragma unroll 1
    for (int l = 0; l < 4; ++l) {
        const int j = l >> 1; const bool attn = (l & 1) != 0;
        {
            pg8::Gemm g{XA, (const bf16_t*)(p.ws + WS_WTIN) + (size_t)l * 4096 * 1024, MT, 4096, 1024};
            pg8::StaticOrder S; S.init(MT, 4096, (int)gridDim.x, (int)blockIdx.x);
            EpiIn E;
            E.mode = attn ? 1 : 0; E.ssq = SSQ; E.lb = (const float*)(p.ws + WS_LB) + j * 1024; E.qn = p.attn_q_norm + j * 64; E.kn = p.attn_k_norm + j * 64;
            E.QB = (bf16_t*)(p.ws + WS_QB); E.KB = (bf16_t*)(p.ws + WS_KB); E.VB = (bf16_t*)(p.ws + WS_VB); E.ZB = (bf16_t*)(p.ws + WS_ZB);
            E.KC = (bf16_t*)(p.ws + WS_KC) + (size_t)j * 16 * KVS * 1024; E.VC = (bf16_t*)(p.ws + WS_VC) + (size_t)j * 16 * KVS * 1024;
            E.okp = p.out + O_KP + (size_t)j * MP * 1024; E.ovp = p.out + O_VP + (size_t)j * MP * 1024; E.oks = p.out + O_KS + (size_t)j * MS * 1024; E.ovs = p.out + O_VS + (size_t)j * MS * 1024;
            pg8::gemm_phase<EpiIn, pg8::StaticOrder, false>(lds, g, S, E, nullptr);
        }
        grid.sync();
        if (attn) attn_phase(p, lds, j, l); else gla_phase(p, lds, j);
        grid.sync();
        {
            pg8::Gemm g{AO, (const bf16_t*)(p.ws + WS_WTOUT) + (size_t)l * 1024 * 1024, MT, 1024, 1024};
            pg8::StaticOrder S; S.init(MT, 1024, (int)gridDim.x, (int)blockIdx.x);
            EpiOut E;
            E.xp = l == 0 ? p.x_prompt : p.out + O_YP; E.xs = l == 0 ? p.x_sample : p.out + O_YS; E.out = p.out; E.XA = XA; E.ssq = SSQ; E.ossq = attn ? nullptr : OSSQ;
            pg8::gemm_phase<EpiOut, pg8::StaticOrder, false>(lds, g, S, E, nullptr);
        }
        if (l < 3) grid.sync();
    }
}

extern "C" void kernel_launch(void* const* d_in, const int* in_sizes, int n_in, void* d_out, int out_size, void* d_ws, size_t ws_size, hipStream_t stream) {
    static int grid = 0;
    if (grid == 0) {
        if (n_in != 16 || ws_size < WS_END) { fprintf(stderr, "kernel_launch: unexpected n_in %d / ws_size %zu\n", n_in, ws_size); grid = -1; return; }
        int dev = 0, cus = 0, per_cu = 0;
        hipGetDevice(&dev); hipDeviceGetAttribute(&cus, hipDeviceAttributeMultiprocessorCount, dev);
        if (hipFuncSetAttribute((const void*)mega_fwd, hipFuncAttributeMaxDynamicSharedMemorySize, LDS_BYTES) != hipSuccess) fprintf(stderr, "kernel_launch: hipFuncSetAttribute failed\n");
        if (hipOccupancyMaxActiveBlocksPerMultiprocessor(&per_cu, (const void*)mega_fwd, 512, LDS_BYTES) != hipSuccess || per_cu < 1) { fprintf(stderr, "kernel_launch: occupancy query gave %d\n", per_cu); per_cu = 1; }
        (void)hipGetLastError();
        grid = cus * per_cu;
    }
    if (grid < 0) return;
    Params p{};
    p.x_prompt = (const float*)d_in[0]; p.x_sample = (const float*)d_in[1]; p.cache_k = (const float*)d_in[2]; p.cache_v = (const float*)d_in[3]; p.state_hgrn = (const float*)d_in[4];
    p.norm_w = (const float*)d_in[5]; p.hgrn_w_in = (const float*)d_in[6]; p.hgrn_lb_logits = (const float*)d_in[7]; p.hgrn_onorm_w = (const float*)d_in[8]; p.hgrn_w_out = (const float*)d_in[9];
    p.attn_w_in = (const float*)d_in[10]; p.attn_q_norm = (const float*)d_in[11]; p.attn_k_norm = (const float*)d_in[12]; p.attn_lambda = (const float*)d_in[13]; p.attn_subln = (const float*)d_in[14];
    p.attn_w_out = (const float*)d_in[15];
    p.out = (float*)d_out; p.ws = (unsigned char*)d_ws;
    void* args[] = {&p};
    hipError_t e = hipLaunchCooperativeKernel((const void*)mega_fwd, dim3(grid), dim3(512), args, LDS_BYTES, stream);
    if (e != hipSuccess) fprintf(stderr, "cooperative launch failed: %s (grid %d)\n", hipGetErrorString(e), grid);
}
```

```cpp
#include <hip/hip_runtime.h>
#include <hip/hip_cooperative_groups.h>
#include <cstdio>
#include <cstdint>
namespace cg = cooperative_groups;
namespace pg8 {
#define PG8_LAS __attribute__((address_space(3)))
typedef unsigned short bf16_t;
typedef short bf16x8 __attribute__((ext_vector_type(8)));
typedef float f32x4 __attribute__((ext_vector_type(4)));
typedef unsigned u32x4 __attribute__((ext_vector_type(4)));
constexpr int BM = 256, BK = 64, HALF = 128, HTB = HALF * BK * 2  , STAGE_BYTES = 8 * HTB, NXCD = 8, WGM = 8;

__host__ __device__ __forceinline__ int lds_byte(int r, int c) { const int st = (r >> 4) * 2 + (c >> 5), rr = r & 15, cc = c & 31, ob = rr * 64 + cc * 2; return st * 1024 + (ob ^ (((ob >> 9) & 1) << 5)); }
__host__ __device__ __forceinline__ void stage_rc(int b, int& R, int& C) { const int st = b / 1024, sb = b % 1024, swz = sb ^ (((sb >> 9) & 1) << 5); R = (st >> 1) * 16 + swz / 64; C = (st & 1) * 32 + (swz % 64) / 2; }
__host__ __device__ __forceinline__ int perm32(int rho) { const int n = rho >> 4, i = rho & 15; return 8 * (i >> 2) + 4 * n + (i & 3); }

struct Unit { int pm, pn; };
struct Gemm { const bf16_t* A; const bf16_t* Bt; int M, N, K; };

struct StaticOrder {
    int nM, nN, nwg, G, c;
    __host__ __device__ void init(int M, int N, int G_, int c_) { nM = M / BM; nN = N / BM; nwg = nM * nN; G = G_; c = c_; }
    __host__ __device__ bool next(int i, Unit& u) const {
        const long L = (long)i * G + c; if (L >= nwg) return false;
        int wgid = (int)L; { const int q = nwg / NXCD, r = nwg % NXCD, xcd = wgid % NXCD, off = wgid / NXCD; wgid = (xcd < r ? xcd * (q + 1) : r * (q + 1) + (xcd - r) * q) + off; }
        const int nig = WGM * nN, gid = wgid / nig, fm = gid * WGM, gsz = (nM - fm) < WGM ? (nM - fm) : WGM;
        u.pm = fm + ((wgid % nig) % gsz); u.pn = (wgid % nig) / gsz; return true;
    }
    __device__ __forceinline__ void a_ready(const Unit&) const {}
    __device__ __forceinline__ void done(const Unit&) const {}
};
__device__ __forceinline__ unsigned cvt_pk_bf16(float lo, float hi) { unsigned r; asm volatile("v_cvt_pk_bf16_f32 %0, %1, %2" : "=v"(r) : "v"(lo), "v"(hi)); return r; }
template <class Epi, class Sched, bool STAMP = false>
__device__ __forceinline__ void gemm_phase(PG8_LAS unsigned char* lds, const Gemm g, const Sched& S, const Epi& E, unsigned long long* stamps) {
    int tid_l = threadIdx.x; asm volatile("" : "+v"(tid_l));
    const int tid = tid_l, wid = __builtin_amdgcn_readfirstlane(tid >> 6), lane = tid & 63, wr = wid >> 2, wc = wid & 3, fr = lane & 15, fq = lane >> 4;
    const int K = g.K, nt = K / BK;
    int ts_lo = 0, ts_hi = 0, nts = 0; const unsigned long long rt_entry = STAMP ? (unsigned long long)wall_clock64() : 0ull;
#define PG8_STAMP() do { if (STAMP && wid == 0 && nts < 64) { const unsigned long long _c = (unsigned long long)clock64(); \
        ts_lo = (lane == nts) ? (int)(unsigned)_c : ts_lo; ts_hi = (lane == nts) ? (int)(unsigned)(_c >> 32) : ts_hi; ++nts; } } while (0)
    PG8_STAMP();
    unsigned voffA[2], voffB[2];
#pragma unroll
    for (int i = 0; i < 2; ++i) { int R, C; stage_rc(tid * 16 + i * 8192, R, C); const int Rb = Epi::PERM ? ((R & ~31) + perm32(R & 31)) : R;
        voffA[i] = (unsigned)(R * K + C) * 2u; voffB[i] = (unsigned)(Rb * K + C) * 2u; }
    const size_t kstep = (size_t)(BK * 2);
    const size_t hstep = (size_t)HALF * K * 2;
    const size_t tstep = 2 * hstep;
    const unsigned ldsw = (unsigned)wid * 1024u;
    const int aoff = lds_byte(wr * 64 + fr, fq * 8), boff = lds_byte(wc * 32 + fr, fq * 8);
#define PG8_SA(b, h) (((b) * 2 + (h)) * HTB)
#define PG8_SB(b, h) ((4 + (b) * 2 + (h)) * HTB)
#define PG8_STAGE(bufoff, gbase, voff) do { _Pragma("unroll") for (int _i = 0; _i < 2; ++_i) \
        __builtin_amdgcn_global_load_lds((const unsigned*)((const char*)(gbase) + (voff)[_i]), (PG8_LAS unsigned*)(lds + (bufoff) + ldsw + _i * 8192), 16, 0, 0); } while (0)
#define PG8_LDA(dst, b, h) do { _Pragma("unroll") for (int m = 0; m < 4; ++m) _Pragma("unroll") for (int k = 0; k < 2; ++k) dst[m][k] = *(const PG8_LAS bf16x8*)(lds + PG8_SA(b, h) + aoff + m * 2048 + k * 1024); } while (0)
#define PG8_LDB(dst, b, h) do { _Pragma("unroll") for (int n = 0; n < 2; ++n) _Pragma("unroll") for (int k = 0; k < 2; ++k) dst[n][k] = *(const PG8_LAS bf16x8*)(lds + PG8_SB(b, h) + boff + n * 2048 + k * 1024); } while (0)
#define PG8_MMA(ai, bj, At, Bt) do { __builtin_amdgcn_s_setprio(1); _Pragma("unroll") for (int m = 0; m < 4; ++m) _Pragma("unroll") for (int n = 0; n < 2; ++n) _Pragma("unroll") for (int k = 0; k < 2; ++k) \
        acc[ai][bj][m][n] = __builtin_amdgcn_mfma_f32_16x16x32_bf16(Bt[n][k], At[m][k], acc[ai][bj][m][n], 0, 0, 0); __builtin_amdgcn_s_setprio(0); } while (0)
#define PG8_WAIT_V(n) asm volatile("s_waitcnt vmcnt(" #n ")" ::: "memory")
#define PG8_WAIT_L(n) asm volatile("s_waitcnt lgkmcnt(" #n ")" ::: "memory")
#define PG8_BAR __builtin_amdgcn_s_barrier()
#define PG8_SCHED __builtin_amdgcn_sched_barrier(0)
    Unit cur, nxt; int ui = 0;
    if (!S.next(0, cur)) return;
    f32x4 acc[2][2][4][2];
#pragma unroll
    for (int a = 0; a < 2; ++a)
#pragma unroll
        for (int b = 0; b < 2; ++b)
#pragma unroll
            for (int m = 0; m < 4; ++m)
#pragma unroll
                for (int n = 0; n < 2; ++n) acc[a][b][m][n] = (f32x4){0.f, 0.f, 0.f, 0.f};
    bf16x8 At[4][2], B0[2][2], B1[2][2];
    const char* cA = (const char*)g.A + (size_t)cur.pm * tstep; const char* cB = (const char*)g.Bt + (size_t)cur.pn * tstep;
    S.a_ready(cur);
    PG8_STAGE(PG8_SB(0, 0), cB, voffB); PG8_STAGE(PG8_SA(0, 0), cA, voffA); PG8_STAGE(PG8_SB(0, 1), cB + hstep, voffB); PG8_STAGE(PG8_SA(0, 1), cA + hstep, voffA);
    if (wr == 1) PG8_BAR;
    PG8_WAIT_V(4); PG8_BAR;
    PG8_STAGE(PG8_SB(1, 0), cB + kstep, voffB); PG8_STAGE(PG8_SA(1, 0), cA + kstep, voffA); PG8_STAGE(PG8_SB(1, 1), cB + hstep + kstep, voffB);
    PG8_WAIT_V(6); PG8_BAR;
    PG8_STAMP();
    for (;;) {
        const bool has_next = S.next(ui + 1, nxt);
        const char* nA = has_next ? (const char*)g.A + (size_t)nxt.pm * tstep : cA; const char* nB = has_next ? (const char*)g.Bt + (size_t)nxt.pn * tstep : cB;
        for (int t = 0; t < nt; t += 2) {
            const bool last = (t == nt - 2);
            const char* a1 = cA + (size_t)(t + 1) * kstep;
            const char* a2 = last ? nA : cA + (size_t)(t + 2) * kstep; const char* b2 = last ? nB : cB + (size_t)(t + 2) * kstep;
            const char* a3 = a2 + kstep; const char* b3 = b2 + kstep;
            if (last && has_next) S.a_ready(nxt);
            PG8_LDB(B0, 0, 0); PG8_SCHED; PG8_LDA(At, 0, 0); PG8_STAGE(PG8_SA(1, 1), a1 + hstep, voffA);
            PG8_WAIT_L(8); PG8_BAR; PG8_WAIT_L(0); PG8_MMA(0, 0, At, B0); PG8_BAR; PG8_SCHED;
            PG8_LDB(B1, 0, 1); PG8_STAGE(PG8_SB(0, 0), b2, voffB);
            PG8_BAR; PG8_WAIT_L(0); PG8_MMA(0, 1, At, B1); PG8_BAR;
            PG8_LDA(At, 0, 1); PG8_STAGE(PG8_SA(0, 0), a2, voffA);
            PG8_BAR; PG8_WAIT_L(0); PG8_MMA(1, 0, At, B0); PG8_BAR; PG8_SCHED;
            PG8_STAGE(PG8_SB(0, 1), b2 + hstep, voffB);
            PG8_WAIT_V(6); PG8_BAR; PG8_MMA(1, 1, At, B1); PG8_BAR;
            PG8_LDB(B0, 1, 0); PG8_SCHED; PG8_LDA(At, 1, 0); PG8_STAGE(PG8_SA(0, 1), a2 + hstep, voffA);
            PG8_WAIT_L(8); PG8_BAR; PG8_WAIT_L(0); PG8_MMA(0, 0, At, B0); PG8_BAR; PG8_SCHED;
            PG8_LDB(B1, 1, 1); PG8_STAGE(PG8_SB(1, 0), b3, voffB);
            PG8_BAR; PG8_WAIT_L(0); PG8_MMA(0, 1, At, B1); PG8_BAR;
            PG8_LDA(At, 1, 1); PG8_STAGE(PG8_SA(1, 0), a3, voffA);
            PG8_BAR; PG8_WAIT_L(0); PG8_MMA(1, 0, At, B0); PG8_BAR; PG8_SCHED;
            PG8_STAGE(PG8_SB(1, 1), b3 + hstep, voffB);
            PG8_WAIT_V(6); PG8_BAR; PG8_MMA(1, 1, At, B1); PG8_BAR;
        }
        PG8_STAMP();
        if constexpr (!Epi::AFTER_DRAIN) { E(acc, cur, wr, wc, fr, fq); S.done(cur); }
        PG8_STAMP();
        if (!has_next) break;
#pragma unroll
        for (int a = 0; a < 2; ++a)
#pragma unroll
            for (int b = 0; b < 2; ++b)
#pragma unroll
                for (int m = 0; m < 4; ++m)
#pragma unroll
                    for (int n = 0; n < 2; ++n) acc[a][b][m][n] = (f32x4){0.f, 0.f, 0.f, 0.f};
        cur = nxt; cA = nA; cB = nB; ++ui;
    }
    PG8_WAIT_V(0);
    if (wr == 0) PG8_BAR;
    PG8_BAR;
    if constexpr (Epi::AFTER_DRAIN) { E.fused(acc, cur, wr, wc, fr, fq, lds, wid, lane); S.done(cur); }
    PG8_STAMP();
    if (STAMP && wid == 0) { stamps[lane] = lane < nts ? (((unsigned long long)(unsigned)ts_hi << 32) | (unsigned)ts_lo) : 0ull;
        if (lane == 62) stamps[62] = rt_entry; if (lane == 63) stamps[63] = (unsigned long long)wall_clock64(); }
#undef PG8_STAMP
#undef PG8_SA
#undef PG8_SB
#undef PG8_STAGE
#undef PG8_LDA
#undef PG8_LDB
#undef PG8_MMA
#undef PG8_WAIT_V
#undef PG8_WAIT_L
#undef PG8_BAR
#undef PG8_SCHED
}
}

#define LAS __attribute__((address_space(3)))
using pg8::bf16_t; using pg8::bf16x8; using pg8::f32x4; using pg8::u32x4;
typedef short bf16x4 __attribute__((ext_vector_type(4)));
typedef float f32x16 __attribute__((ext_vector_type(16)));
typedef unsigned u32x2 __attribute__((ext_vector_type(2)));
typedef short v4i16_t __attribute__((ext_vector_type(4)));

constexpr int DM = 1024, MP = 65536, MS = 1024, MT = MP + MS, KVS = 2112;
constexpr float EPS = 1e-6f, LOG2E = 1.4426950408889634f;
constexpr size_t O_YP = 0, O_YS = 67108864, O_KP = 68157440, O_VP = 202375168, O_KS = 336592896, O_VS = 338690048, O_SP = 340787200, O_SS = 349175808;
constexpr size_t MiB = 1u << 20;
constexpr size_t WS_WTIN = 0, WS_WTOUT = 32 * MiB, WS_LB = 40 * MiB, WS_SSQ = 41 * MiB, WS_OSSQ = 46 * MiB, WS_XA = 64 * MiB, WS_QB = 200 * MiB, WS_KB = 336 * MiB,
                 WS_VB = 472 * MiB, WS_ZB = 608 * MiB, WS_AO = 744 * MiB, WS_KC = 880 * MiB, WS_VC = 1016 * MiB, WS_END = 1152 * MiB;
constexpr int LDS_BYTES = 147456;

struct Params {
    const float *x_prompt, *x_sample, *cache_k, *cache_v, *state_hgrn, *norm_w, *hgrn_w_in, *hgrn_lb_logits, *hgrn_onorm_w, *hgrn_w_out,
                *attn_w_in, *attn_q_norm, *attn_k_norm, *attn_lambda, *attn_subln, *attn_w_out;
    float* out; unsigned char* ws;
};

__device__ __forceinline__ unsigned pk2(float lo, float hi) { typedef float f2 __attribute__((ext_vector_type(2))); typedef __bf16 b2 __attribute__((ext_vector_type(2)));
    f2 v = {lo, hi}; b2 b = __builtin_convertvector(v, b2); return __builtin_bit_cast(unsigned, b); }
__device__ __forceinline__ float bflo(unsigned u) { return __uint_as_float(u << 16); }
__device__ __forceinline__ float bfhi(unsigned u) { return __uint_as_float(u & 0xffff0000u); }
__device__ __forceinline__ float wave_sum(float v) {
#pragma unroll
    for (int o = 32; o > 0; o >>= 1) v += __shfl_xor(v, o);
    return v; }
__device__ __forceinline__ float ex2(float x) { return __builtin_amdgcn_exp2f(x); }
__device__ __forceinline__ u32x4 pack8(f32x4 a, f32x4 b) { u32x4 r; r[0] = pk2(a[0], a[1]); r[1] = pk2(a[2], a[3]); r[2] = pk2(b[0], b[1]); r[3] = pk2(b[2], b[3]); return r; }

struct EpiIn {
    static constexpr bool PERM = true, AFTER_DRAIN = false;
    int mode, j;
    unsigned char* ws; float* outb; const float* qnb; const float* knb;
    __device__ __forceinline__ void operator()(const f32x4 (&acc)[2][2][4][2], const pg8::Unit& u, int wr, int wc, int fr, int fq) const {
        const float* ssq = (const float*)(ws + WS_SSQ); const float* lb = (const float*)(ws + WS_LB) + j * 1024; const float* qn = qnb + j * 64; const float* kn = knb + j * 64;
        bf16_t* QB = (bf16_t*)(ws + WS_QB); bf16_t* KB = (bf16_t*)(ws + WS_KB); bf16_t* VB = (bf16_t*)(ws + WS_VB); bf16_t* ZB = (bf16_t*)(ws + WS_ZB);
        bf16_t* KC = (bf16_t*)(ws + WS_KC) + (size_t)j * 16 * KVS * 1024; bf16_t* VC = (bf16_t*)(ws + WS_VC) + (size_t)j * 16 * KVS * 1024;
        float* okp = outb + O_KP + (size_t)j * MP * 1024; float* ovp = outb + O_VP + (size_t)j * MP * 1024; float* oks = outb + O_KS + (size_t)j * MS * 1024; float* ovs = outb + O_VS + (size_t)j * MS * 1024;
        const int region = u.pn >> 2, pg = u.pn & 3;
        const int cb = pg * 256 + wc * 64 + 8 * fq;
        const bool samp = u.pm >= 256;
        float rsv[2][4];
#pragma unroll
        for (int ai = 0; ai < 2; ++ai)
#pragma unroll
            for (int m = 0; m < 4; ++m) { const int row = u.pm * 256 + ai * 128 + wr * 64 + m * 16 + fr;
                const f32x4 s4 = *(const f32x4*)(ssq + (size_t)row * 16 + 4 * fq); rsv[ai][m] = (s4[0] + s4[1]) + (s4[2] + s4[3]); }
#pragma unroll
        for (int ai = 0; ai < 2; ++ai)
#pragma unroll
            for (int m = 0; m < 4; ++m) { float t = rsv[ai][m]; t += __shfl_xor(t, 16); t += __shfl_xor(t, 32); rsv[ai][m] = rsqrtf(t * (1.f / 1024.f) + EPS); }
        f32x4 wq[2][2];
        { const float* wb = mode == 0 ? lb + cb : (region == 0 ? qn : kn) + 8 * fq;
#pragma unroll
          for (int bj = 0; bj < 2; ++bj)
#pragma unroll
              for (int n = 0; n < 2; ++n) wq[bj][n] = *(const f32x4*)(wb + 32 * bj + 4 * n); }
#pragma unroll
        for (int ai = 0; ai < 2; ++ai)
#pragma unroll
            for (int m = 0; m < 4; ++m) {
                const int row = u.pm * 256 + ai * 128 + wr * 64 + m * 16 + fr;
                const float rs = rsv[ai][m];
                f32x4 v[2][2];
#pragma unroll
                for (int bj = 0; bj < 2; ++bj)
#pragma unroll
                    for (int n = 0; n < 2; ++n) v[bj][n] = acc[ai][bj][m][n] * rs;
                if (region == 3) {
#pragma unroll
                    for (int bj = 0; bj < 2; ++bj) {
#pragma unroll
                        for (int n = 0; n < 2; ++n)
#pragma unroll
                            for (int j = 0; j < 4; ++j) { const float x = v[bj][n][j]; v[bj][n][j] = x * __builtin_amdgcn_rcpf(1.f + ex2(-LOG2E * x)); }
                        *(u32x4*)(ZB + (size_t)row * 1024 + cb + 32 * bj) = pack8(v[bj][0], v[bj][1]);
                    }
                } else if (mode == 0) {
                    if (region == 0) {
#pragma unroll
                        for (int bj = 0; bj < 2; ++bj) *(u32x4*)(QB + (size_t)row * 1024 + cb + 32 * bj) = pack8(v[bj][0] * 0.08838834764831845f, v[bj][1] * 0.08838834764831845f);
                    } else if (region == 1) {
#pragma unroll
                        for (int bj = 0; bj < 2; ++bj) {
#pragma unroll
                            for (int n = 0; n < 2; ++n) { const f32x4 l4 = wq[bj][n];
#pragma unroll
                                for (int j = 0; j < 4; ++j) { const float sg = __builtin_amdgcn_rcpf(1.f + ex2(-LOG2E * v[bj][n][j])); const float f = l4[j] + (1.f - l4[j]) * sg; v[bj][n][j] = __builtin_amdgcn_logf(f); } }
                            *(u32x4*)(KB + (size_t)row * 1024 + cb + 32 * bj) = pack8(v[bj][0], v[bj][1]);
                        }
                    } else {
#pragma unroll
                        for (int bj = 0; bj < 2; ++bj) *(u32x4*)(VB + (size_t)row * 1024 + cb + 32 * bj) = pack8(v[bj][0], v[bj][1]);
                    }
                } else {
                    const int srow = row - MP;
                    const size_t crow = samp ? (size_t)(srow >> 6) * KVS + 2048 + (srow & 63) : 0;
                    if (region <= 1) {
                        float ss = 0.f;
#pragma unroll
                        for (int bj = 0; bj < 2; ++bj)
#pragma unroll
                            for (int n = 0; n < 2; ++n)
#pragma unroll
                                for (int j = 0; j < 4; ++j) ss += v[bj][n][j] * v[bj][n][j];
                        ss += __shfl_xor(ss, 16); ss += __shfl_xor(ss, 32);
                        float r2 = rsqrtf(ss * (1.f / 64.f) + EPS);
                        if (region == 0) r2 *= 0.125f * LOG2E;
#pragma unroll
                        for (int bj = 0; bj < 2; ++bj)
#pragma unroll
                            for (int n = 0; n < 2; ++n) v[bj][n] = v[bj][n] * wq[bj][n] * r2;
                        if (region == 0) {
#pragma unroll
                            for (int bj = 0; bj < 2; ++bj) *(u32x4*)(QB + (size_t)row * 1024 + cb + 32 * bj) = pack8(v[bj][0], v[bj][1]);
                        } else {
                            float* of = samp ? oks + (size_t)srow * 1024 : okp + (size_t)row * 1024;
                            bf16_t* ob = samp ? KC + crow * 1024 : KB + (size_t)row * 1024;
#pragma unroll
                            for (int bj = 0; bj < 2; ++bj) { __builtin_nontemporal_store(v[bj][0], (f32x4*)(of + cb + 32 * bj)); __builtin_nontemporal_store(v[bj][1], (f32x4*)(of + cb + 32 * bj + 4)); *(u32x4*)(ob + cb + 32 * bj) = pack8(v[bj][0], v[bj][1]); }
                        }
                    } else {
                        float* of = samp ? ovs + (size_t)srow * 1024 : ovp + (size_t)row * 1024;
                        bf16_t* ob = samp ? VC + crow * 1024 : VB + (size_t)row * 1024;
#pragma unroll
                        for (int bj = 0; bj < 2; ++bj) { __builtin_nontemporal_store(v[bj][0], (f32x4*)(of + cb + 32 * bj)); __builtin_nontemporal_store(v[bj][1], (f32x4*)(of + cb + 32 * bj + 4)); *(u32x4*)(ob + cb + 32 * bj) = pack8(v[bj][0], v[bj][1]); }
                    }
                }
            }
    }
};

struct EpiOut {
    static constexpr bool PERM = true, AFTER_DRAIN = false;
    float* out;
    bf16_t* XA;
    float* ssq;
    const float* ossq;
    __device__ __forceinline__ void operator()(const f32x4 (&acc)[2][2][4][2], const pg8::Unit& u, int wr, int wc, int fr, int fq) const {
        const int cb = u.pn * 256 + wc * 32 + 8 * fq;
        float rsv[8];
        if (ossq) {
#pragma unroll
            for (int r = 0; r < 8; ++r) { const int row = u.pm * 256 + (r >> 2) * 128 + wr * 64 + (r & 3) * 16 + fr;
                const f32x4 s4 = *(const f32x4*)(ossq + (size_t)row * 8 + 4 * (fq & 1)); rsv[r] = (s4[0] + s4[1]) + (s4[2] + s4[3]); }
#pragma unroll
            for (int r = 0; r < 8; ++r) { float t = rsv[r]; t += __shfl_xor(t, 16); rsv[r] = rsqrtf(t * (1.f / 1024.f) + EPS); }
        } else {
#pragma unroll
            for (int r = 0; r < 8; ++r) rsv[r] = 1.f;
        }
        u32x4 xq[4][2];
#pragma unroll
        for (int r = 0; r < 3; ++r) { const int row = u.pm * 256 + (r >> 2) * 128 + wr * 64 + (r & 3) * 16 + fr;
#pragma unroll
            for (int bj = 0; bj < 2; ++bj) xq[r][bj] = *(const u32x4*)(XA + (size_t)row * 1024 + cb + 128 * bj); }
#pragma unroll
        for (int r = 0; r < 8; ++r) {
            const int ai = r >> 2, m = r & 3;
            const int row = u.pm * 256 + ai * 128 + wr * 64 + m * 16 + fr;
            if (r + 3 < 8) { const int rn = r + 3, rown = u.pm * 256 + (rn >> 2) * 128 + wr * 64 + (rn & 3) * 16 + fr;
#pragma unroll
                for (int bj = 0; bj < 2; ++bj) xq[rn & 3][bj] = *(const u32x4*)(XA + (size_t)rown * 1024 + cb + 128 * bj); }
            const u32x4* xc = xq[r & 3];
            const float rs = rsv[r];
            float part = 0.f;
#pragma unroll
            for (int bj = 0; bj < 2; ++bj) {
                const int c = cb + 128 * bj;
                f32x4 x0, x1; x0[0] = bflo(xc[bj][0]); x0[1] = bfhi(xc[bj][0]); x0[2] = bflo(xc[bj][1]); x0[3] = bfhi(xc[bj][1]); x1[0] = bflo(xc[bj][2]); x1[1] = bfhi(xc[bj][2]); x1[2] = bflo(xc[bj][3]); x1[3] = bfhi(xc[bj][3]);
                const f32x4 y0 = x0 + acc[ai][bj][m][0] * rs, y1 = x1 + acc[ai][bj][m][1] * rs;
                if (out) { __builtin_nontemporal_store(y0, (f32x4*)(out + (size_t)row * 1024 + c)); __builtin_nontemporal_store(y1, (f32x4*)(out + (size_t)row * 1024 + c + 4)); }
                *(u32x4*)(XA + (size_t)row * 1024 + c) = pack8(y0, y1);
#pragma unroll
                for (int j = 0; j < 4; ++j) part += y0[j] * y0[j] + y1[j] * y1[j];
            }
            part += __shfl_xor(part, 16); part += __shfl_xor(part, 32);
            if (fq == 0) ssq[(size_t)row * 16 + u.pn * 4 + wc] = part;
        }
    }
};

__device__ __forceinline__ void phase_skew(int k) {
    const unsigned long long t0 = __builtin_amdgcn_s_memrealtime(); while (__builtin_amdgcn_s_memrealtime() - t0 < (unsigned long long)(k * 600)) __builtin_amdgcn_s_sleep(32);
}

__device__ __forceinline__ void prologue(const Params& p, LAS unsigned char* lds) {
    int tid = threadIdx.x; asm volatile("" : "+v"(tid));
    const int G = gridDim.x, bx = blockIdx.x, wave = tid >> 6, lane = tid & 63;
    LAS float* ts = (LAS float*)lds;
    bf16_t* wtin = (bf16_t*)(p.ws + WS_WTIN); bf16_t* wtout = (bf16_t*)(p.ws + WS_WTOUT);
    for (int tile = bx; tile < 5120; tile += G) {
        const float* W; bf16_t* WT; int N, ntile, ktile; const float* nw = nullptr; bool perm;
        if (tile < 4096) { const int l = tile >> 10, t = tile & 1023; ntile = t >> 3; ktile = t & 7; N = 4096; perm = true;
            W = ((l & 1) ? p.attn_w_in : p.hgrn_w_in) + (size_t)(l >> 1) * 1024 * 4096; WT = wtin + (size_t)l * 4096 * 1024; nw = p.norm_w + l * 1024; }
        else { const int t2 = tile - 4096, l = t2 >> 8, t = t2 & 255; ntile = t >> 3; ktile = t & 7; N = 1024; perm = false;
            W = ((l & 1) ? p.attn_w_out : p.hgrn_w_out) + (size_t)(l >> 1) * 1024 * 1024; WT = wtout + (size_t)l * 1024 * 1024; }
        const int vcol0 = ntile * 32, k0 = ktile * 128;
        int real0 = vcol0;
        if (perm) { const int region = vcol0 >> 10, rv = vcol0 & 1023, pg = rv >> 8, rem = rv & 255, bj = rem >> 7, wc = (rem & 127) >> 5; real0 = region * 1024 + pg * 256 + wc * 64 + bj * 32; }
#pragma unroll
        for (int i = 0; i < 2; ++i) { const int k = (tid >> 3) + 64 * i, c4 = (tid & 7) * 4;
            const f32x4 v = *(const f32x4*)(W + (size_t)(k0 + k) * N + real0 + c4); const float s = nw ? nw[k0 + k] : 1.f;
#pragma unroll
            for (int e = 0; e < 4; ++e) ts[k * 33 + c4 + e] = v[e] * s; }
        __syncthreads();
        { const int n = tid >> 4, ks = (tid & 15) * 8; f32x4 a, b;
#pragma unroll
            for (int e = 0; e < 4; ++e) { a[e] = ts[(ks + e) * 33 + n]; b[e] = ts[(ks + 4 + e) * 33 + n]; }
            *(u32x4*)(WT + (size_t)(vcol0 + n) * 1024 + k0 + ks) = pack8(a, b); }
        __syncthreads();
    }
    bf16_t* XA = (bf16_t*)(p.ws + WS_XA); float* SSQ = (float*)(p.ws + WS_SSQ);
    for (int row = bx * 8 + wave; row < MT; row += G * 8) {
        const float* xr = row < MP ? p.x_prompt + (size_t)row * 1024 : p.x_sample + (size_t)(row - MP) * 1024;
        float ss = 0.f;
#pragma unroll
        for (int i = 0; i < 4; ++i) { const f32x4 v = *(const f32x4*)(xr + (lane + 64 * i) * 4); ss += v[0] * v[0] + v[1] * v[1] + v[2] * v[2] + v[3] * v[3];
            u32x2 o; o[0] = pk2(v[0], v[1]); o[1] = pk2(v[2], v[3]); *(u32x2*)(XA + (size_t)row * 1024 + (lane + 64 * i) * 4) = o; }
        ss = wave_sum(ss);
        if (lane < 16) SSQ[(size_t)row * 16 + lane] = lane == 0 ? ss : 0.f;
    }
    { bf16_t* KC = (bf16_t*)(p.ws + WS_KC); bf16_t* VC = (bf16_t*)(p.ws + WS_VC);
      const size_t n8 = (size_t)2 * 16 * 2048 * 1024 / 8;
      for (size_t i0 = (size_t)bx * 2048 + tid; i0 < 2 * n8; i0 += (size_t)G * 2048) {
          f32x4 va[4], vb[4]; bf16_t* dst[4];
#pragma unroll
          for (int q = 0; q < 4; ++q) { const size_t i = i0 + 512 * q; const bool wh = i >= n8; const size_t e = (wh ? i - n8 : i) * 8; const size_t jb = e >> 21, rem = e & ((1u << 21) - 1);
              const float* src = (wh ? p.cache_v : p.cache_k) + e; dst[q] = (wh ? VC : KC) + jb * ((size_t)KVS * 1024) + rem;
              va[q] = __builtin_nontemporal_load((const f32x4*)src); vb[q] = __builtin_nontemporal_load((const f32x4*)src + 1); }
#pragma unroll
          for (int q = 0; q < 4; ++q) *(u32x4*)dst[q] = pack8(va[q], vb[q]);
      } }
    if (bx == 0) { float* LB = (float*)(p.ws + WS_LB);
        for (int c = tid; c < 1024; c += 512) { const float l0 = p.hgrn_lb_logits[c], l1 = p.hgrn_lb_logits[1024 + c]; LB[c] = 0.f; LB[1024 + c] = 1.f / (1.f + expf(l0 - l1)); } }
}

__device__ __forceinline__ f32x4 mfma16(bf16x4 a, bf16x4 b, f32x4 c) { return __builtin_amdgcn_mfma_f32_16x16x16bf16_1k(a, b, c, 0, 0, 0); }
__device__ __forceinline__ bf16x4 pack4(f32x4 a) { u32x2 r; r[0] = pk2(a[0], a[1]); r[1] = pk2(a[2], a[3]); return __builtin_bit_cast(bf16x4, r); }

__device__ __forceinline__ void gla_phase(const Params& p, LAS unsigned char* lds, int j) {
    int tid = threadIdx.x; asm volatile("" : "+v"(tid));
    const int lane = tid & 63, wave = __builtin_amdgcn_readfirstlane(tid >> 6), G = gridDim.x;
    LAS unsigned char* QH = lds; LAS unsigned char* KH = lds + 17408; LAS unsigned char* KT = lds + 34816; LAS unsigned char* VS = lds + 55296;
    LAS float* OB = (LAS float*)(lds + 72704); LAS float* DL = (LAS float*)(lds + 106496);
    const bf16_t* QB = (const bf16_t*)(p.ws + WS_QB); const bf16_t* GB = (const bf16_t*)(p.ws + WS_KB); const bf16_t* VB = (const bf16_t*)(p.ws + WS_VB); const bf16_t* ZB = (const bf16_t*)(p.ws + WS_ZB);
    bf16_t* AO = (bf16_t*)(p.ws + WS_AO); float* OSSQ = (float*)(p.ws + WS_OSSQ);
    for (int item = blockIdx.x; item < 384; item += G) {
        int lane_l = lane; asm volatile("" : "+v"(lane_l));
        const int v = lane_l & 15, kq = lane_l >> 4;
        const int tv = (wave - 4) * 64 + lane_l;
        int b, h, T; size_t row0; const float* S0; float* Sout;
        if (item < 256) { b = item >> 3; h = item & 7; T = 2048; row0 = (size_t)b * 2048; S0 = nullptr; Sout = p.out + O_SP + ((size_t)(j * 32 + b) * 8 + h) * 16384; }
        else { const int it = item - 256; b = it >> 3; h = it & 7; T = 64; row0 = (size_t)MP + b * 64; S0 = p.state_hgrn + ((size_t)(j * 16 + b) * 8 + h) * 16384; Sout = p.out + O_SS + ((size_t)(j * 16 + b) * 8 + h) * 16384; }
        f32x4 S[8];
#pragma unroll
        for (int i = 0; i < 8; ++i) S[i] = (f32x4){0.f, 0.f, 0.f, 0.f};
        if (S0) {
            const float* sp = S0 + (4 * kq) * 128 + 16 * wave + v;
#pragma unroll
            for (int i = 0; i < 8; ++i)
#pragma unroll
                for (int jj = 0; jj < 4; ++jj) S[i][jj] = sp[(16 * i + jj) * 128];
        }
        const int nsteps = T >> 6;
        unsigned rq[16], rg[16]; u32x4 rv[4], rz[4]; f32x4 ow0, ow1;
        const size_t hb = (size_t)h * 128;
        if (wave < 4) {
#pragma unroll
            for (int t = 0; t < 16; ++t) { const size_t r = row0 + wave * 16 + t; rq[t] = *(const unsigned*)(QB + r * 1024 + hb + 2 * lane); rg[t] = *(const unsigned*)(GB + r * 1024 + hb + 2 * lane); }
        } else {
#pragma unroll
            for (int i = 0; i < 4; ++i) { const int idx = tv + 256 * i; rv[i] = *(const u32x4*)(VB + (row0 + (idx >> 4)) * 1024 + hb + (idx & 15) * 8); }
            ow0 = *(const f32x4*)(p.hgrn_onorm_w + j * 1024 + hb + (tv & 15) * 8); ow1 = *(const f32x4*)(p.hgrn_onorm_w + j * 1024 + hb + (tv & 15) * 8 + 4);
        }
        for (int s = 0; s <= nsteps; ++s) {
            if (wave < 4) {
                if (s < nsteps) {
                    float b0 = 0.f, b1 = 0.f;
#pragma unroll
                    for (int t = 0; t < 16; ++t) {
                        const unsigned q2 = rq[t], g2 = rg[t];
                        const float ga = bflo(g2), gb = bfhi(g2);
                        b0 += ga; b1 += gb;
                        const float qa = bflo(q2) * ex2(b0), qb = bfhi(q2) * ex2(b1);
                        const float ka = (1.f - ex2(ga)) * ex2(fminf(-b0, 120.f)), kb = (1.f - ex2(gb)) * ex2(fminf(-b1, 120.f));
                        const int row = wave * 16 + t;
                        *(LAS unsigned*)(QH + row * 272 + lane * 4) = pk2(qa, qb);
                        const unsigned kk = pk2(ka, kb);
                        *(LAS unsigned*)(KH + row * 272 + lane * 4) = kk;
                        *(LAS unsigned short*)(KT + (wave * 128 + 2 * lane) * 40 + t * 2) = (unsigned short)(kk & 0xffffu);
                        *(LAS unsigned short*)(KT + (wave * 128 + 2 * lane + 1) * 40 + t * 2) = (unsigned short)(kk >> 16);
                    }
                    DL[wave * 128 + 2 * lane] = ex2(b0); DL[wave * 128 + 2 * lane + 1] = ex2(b1);
                    if (s + 1 < nsteps) {
#pragma unroll
                        for (int t = 0; t < 16; ++t) { const size_t r = row0 + (s + 1) * 64 + wave * 16 + t; rq[t] = *(const unsigned*)(QB + r * 1024 + hb + 2 * lane); rg[t] = *(const unsigned*)(GB + r * 1024 + hb + 2 * lane); }
                    }
                }
            } else {
                if (s > 0) {
#pragma unroll
                    for (int i = 0; i < 4; ++i) { const int idx = tv + 256 * i, r = idx >> 4, sg = idx & 15;
                        const f32x4 o0 = *(LAS f32x4*)(OB + r * 132 + sg * 8), o1 = *(LAS f32x4*)(OB + r * 132 + sg * 8 + 4);
                        const u32x4 z = rz[i];
                        f32x4 a0, a1;
                        a0[0] = o0[0] * ow0[0] * bflo(z[0]); a0[1] = o0[1] * ow0[1] * bfhi(z[0]); a0[2] = o0[2] * ow0[2] * bflo(z[1]); a0[3] = o0[3] * ow0[3] * bfhi(z[1]);
                        a1[0] = o1[0] * ow1[0] * bflo(z[2]); a1[1] = o1[1] * ow1[1] * bfhi(z[2]); a1[2] = o1[2] * ow1[2] * bflo(z[3]); a1[3] = o1[3] * ow1[3] * bfhi(z[3]);
                        const size_t grow = row0 + (size_t)(s - 1) * 64 + r;
                        *(u32x4*)(AO + grow * 1024 + hb + sg * 8) = pack8(a0, a1);
                        float ss = o0[0] * o0[0] + o0[1] * o0[1] + o0[2] * o0[2] + o0[3] * o0[3] + o1[0] * o1[0] + o1[1] * o1[1] + o1[2] * o1[2] + o1[3] * o1[3];
                        ss += __shfl_xor(ss, 1); ss += __shfl_xor(ss, 2); ss += __shfl_xor(ss, 4); ss += __shfl_xor(ss, 8);
                        if (sg == 0) OSSQ[grow * 8 + h] = ss; }
                }
                if (s < nsteps) {
#pragma unroll
                    for (int i = 0; i < 4; ++i) { const int idx = tv + 256 * i; *(LAS u32x4*)(VS + (idx >> 4) * 272 + (idx & 15) * 16) = rv[i]; }
#pragma unroll
                    for (int i = 0; i < 4; ++i) { const int idx = tv + 256 * i; rz[i] = *(const u32x4*)(ZB + (row0 + (size_t)s * 64 + (idx >> 4)) * 1024 + hb + (idx & 15) * 8); }
                    if (s + 1 < nsteps) {
#pragma unroll
                        for (int i = 0; i < 4; ++i) { const int idx = tv + 256 * i; rv[i] = *(const u32x4*)(VB + (row0 + (size_t)(s + 1) * 64 + (idx >> 4)) * 1024 + hb + (idx & 15) * 8); }
                    }
                }
            }
            __syncthreads();
            if (s == nsteps) break;
#pragma unroll 1
            for (int c = 0; c < 4; ++c) {
                bf16x4 qf[8], kf[8];
#pragma unroll
                for (int i = 0; i < 8; ++i) { qf[i] = *(LAS bf16x4*)(QH + (c * 16 + v) * 272 + (16 * i + 4 * kq) * 2); kf[i] = *(LAS bf16x4*)(KH + (c * 16 + v) * 272 + (16 * i + 4 * kq) * 2); }
                bf16x4 vf;
#pragma unroll
                for (int jj = 0; jj < 4; ++jj) vf[jj] = *(LAS short*)(VS + (c * 16 + 4 * kq + jj) * 272 + (16 * wave + v) * 2);
                f32x4 o0 = {0.f, 0.f, 0.f, 0.f}, o1 = o0, a0 = o0, a1 = o0;
#pragma unroll
                for (int i = 0; i < 8; i += 2) { o0 = mfma16(qf[i], pack4(S[i]), o0); o1 = mfma16(qf[i + 1], pack4(S[i + 1]), o1); a0 = mfma16(kf[i], qf[i], a0); a1 = mfma16(kf[i + 1], qf[i + 1], a1); }
                f32x4 at = a0 + a1;
#pragma unroll
                for (int jj = 0; jj < 4; ++jj) if (4 * kq + jj > v) at[jj] = 0.f;
                f32x4 o = mfma16(pack4(at), vf, o0 + o1);
#pragma unroll
                for (int i = 0; i < 8; ++i) { const bf16x4 ktf = *(LAS bf16x4*)(KT + (c * 128 + 16 * i + v) * 40 + 8 * kq); S[i] = mfma16(ktf, vf, S[i]); }
#pragma unroll
                for (int i = 0; i < 8; ++i) { const f32x4 d = *(LAS f32x4*)(DL + c * 128 + 16 * i + 4 * kq); S[i] = S[i] * d; }
#pragma unroll
                for (int jj = 0; jj < 4; ++jj) OB[(c * 16 + 4 * kq + jj) * 132 + 16 * wave + v] = o[jj];
            }
            __syncthreads();
        }
        { float* so = Sout + (4 * kq) * 128 + 16 * wave + v;
#pragma unroll
        for (int i = 0; i < 8; ++i)
#pragma unroll
            for (int jj = 0; jj < 4; ++jj) so[(16 * i + jj) * 128] = S[i][jj]; }
    }
}

__device__ __forceinline__ f32x16 mfma32(bf16x8 a, bf16x8 b, f32x16 c) { return __builtin_amdgcn_mfma_f32_32x32x16_bf16(a, b, c, 0, 0, 0); }
__device__ __forceinline__ v4i16_t ldtr(const LAS unsigned char* q) { return __builtin_amdgcn_ds_read_tr16_b64_v4i16((LAS v4i16_t*)q); }

__device__ __forceinline__ void attn_unit(LAS unsigned char* lds, const bf16_t* QB, const bf16_t* Kb, const bf16_t* Vb, const bf16_t* ZB, bf16_t* AO, const float* subln,
                                          size_t row0q, int h, int ntiles, int qpos0, int nrg, bool partial, float lam, float osc) {
    int tid = threadIdx.x; asm volatile("" : "+v"(tid));
    const int lane = tid & 63, wave = __builtin_amdgcn_readfirstlane(tid >> 6), rg = wave & 3, mp = wave >> 2, ql = lane & 31, hh = lane >> 5;
    const bool active = rg < nrg;
    const float slope2 = ex2(-(float)(h + 1)) * LOG2E;
    bf16x8 qf[4];
    if (active) {
#pragma unroll
        for (int ks = 0; ks < 4; ++ks) qf[ks] = *(const bf16x8*)(QB + (row0q + rg * 32 + ql) * 1024 + mp * 512 + h * 64 + ks * 16 + hh * 8);
    }
    f32x16 ot[4];
#pragma unroll
    for (int dt = 0; dt < 4; ++dt)
#pragma unroll
        for (int r = 0; r < 16; ++r) ot[dt][r] = 0.f;
    float mrow = 0.f, lrow = 0.f;
    const float qpos = (float)(qpos0 + rg * 32 + ql);
    u32x4 sr[4];
    const int kkey = tid >> 3, kseg = tid & 7, vkey = tid >> 4, vseg = tid & 15;
    const int vsw = (vseg ^ (((vkey & 3) << 2) | ((vkey >> 2) & 3))) * 16;
#define ATT_LOAD(jt) do { \
        sr[0] = *(const u32x4*)(Kb + ((size_t)(jt) * 64 + kkey) * 1024 + h * 64 + kseg * 8); sr[1] = *(const u32x4*)(Kb + ((size_t)(jt) * 64 + kkey) * 1024 + 512 + h * 64 + kseg * 8); \
        sr[2] = *(const u32x4*)(Vb + ((size_t)(jt) * 64 + vkey) * 1024 + h * 128 + vseg * 8); sr[3] = *(const u32x4*)(Vb + ((size_t)(jt) * 64 + vkey + 32) * 1024 + h * 128 + vseg * 8); } while (0)
#define ATT_STORE(buf) do { LAS unsigned char* _b = lds + (buf) * 35840; \
        *(LAS u32x4*)(_b + kkey * 144 + kseg * 16) = sr[0]; *(LAS u32x4*)(_b + 9216 + kkey * 144 + kseg * 16) = sr[1]; \
        *(LAS u32x4*)(_b + 18432 + vkey * 256 + vsw) = sr[2]; *(LAS u32x4*)(_b + 18432 + (vkey + 32) * 256 + vsw) = sr[3]; } while (0)
    ATT_LOAD(ntiles - 1); ATT_STORE(0);
    __syncthreads();
    int vo[4][2];
    { const int fh = (lane >> 2) & 3, cl = 2 * ((lane >> 4) & 1) + ((lane >> 1) & 1);
#pragma unroll
      for (int dt = 0; dt < 4; ++dt)
#pragma unroll
          for (int e = 0; e < 2; ++e) vo[dt][e] = 256 * (4 * hh + fh + 8 * e) + 16 * (((dt ^ fh) << 2) + (cl ^ (hh + 2 * e))) + 8 * (lane & 1); }
#define ATT_LDV(dst, sp) do { const LAS unsigned char* _v = lds + 18432 + buf * 35840 + (((sp) >> 1) * 32 + ((sp) & 1) * 16) * 256; _Pragma("unroll") for (int dt = 0; dt < 4; ++dt) { \
        const v4i16_t lo = ldtr(_v + vo[dt][0]), hi = ldtr(_v + vo[dt][1]); \
        dst[dt][0] = lo[0]; dst[dt][1] = lo[1]; dst[dt][2] = lo[2]; dst[dt][3] = lo[3]; dst[dt][4] = hi[0]; dst[dt][5] = hi[1]; dst[dt][6] = hi[2]; dst[dt][7] = hi[3]; } } while (0)
#define ATT_PACK(pf, kt, s8) do { u32x4 pp; pp[0] = pk2(st[kt][s8 + 0], st[kt][s8 + 1]); pp[1] = pk2(st[kt][s8 + 2], st[kt][s8 + 3]); pp[2] = pk2(st[kt][s8 + 4], st[kt][s8 + 5]); pp[3] = pk2(st[kt][s8 + 6], st[kt][s8 + 7]); pf = __builtin_bit_cast(bf16x8, pp); } while (0)
    for (int it = 0; it < ntiles; ++it) {
        const int jt = ntiles - 1 - it;
        const int buf = it & 1;
        if (it + 1 < ntiles) ATT_LOAD(jt - 1);
        const bool doit = active && !(partial && it == 0 && rg < 2);
        if (doit) {
            const LAS unsigned char* Kt = lds + buf * 35840 + mp * 9216;
            bf16x8 kfr[2][4];
#pragma unroll
            for (int kt = 0; kt < 2; ++kt)
#pragma unroll
                for (int ks = 0; ks < 4; ++ks) kfr[kt][ks] = *(LAS bf16x8*)(Kt + (kt * 32 + ql) * 144 + ks * 32 + hh * 16);
            __builtin_amdgcn_sched_barrier(0);
            f32x16 st[2];
            const float dq = qpos - (float)(jt * 64 + 4 * hh);
            { float nsl = -slope2, nm = -mrow; asm volatile("" : "+v"(nsl), "+v"(nm));
#pragma unroll
              for (int kt = 0; kt < 2; ++kt)
#pragma unroll
                for (int r = 0; r < 16; ++r) st[kt][r] = fmaf(nsl, fabsf(dq - (float)(kt * 32 + (r & 3) + 8 * (r >> 2))), nm); }
            __builtin_amdgcn_s_setprio(1);
#pragma unroll
            for (int ks = 0; ks < 4; ++ks) { st[0] = mfma32(kfr[0][ks], qf[ks], st[0]); st[1] = mfma32(kfr[1][ks], qf[ks], st[1]); }
            __builtin_amdgcn_s_setprio(0);
            bf16x8 vf0[4], vf1[4];
            ATT_LDV(vf0, 0); ATT_LDV(vf1, 1);
            __builtin_amdgcn_sched_barrier(0);
            float mx = fmaxf(st[0][0], st[1][0]);
#pragma unroll
            for (int r = 1; r < 16; ++r) mx = fmaxf(mx, fmaxf(st[0][r], st[1][r]));
            mx = fmaxf(mx, __shfl_xor(mx, 32));
            if (__any(mx > 8.f)) {
                const float up = fmaxf(mx, 0.f), alpha = ex2(-up); mrow += up; lrow *= alpha;
#pragma unroll
                for (int dt = 0; dt < 4; ++dt) ot[dt] = ot[dt] * alpha;
#pragma unroll
                for (int kt = 0; kt < 2; ++kt)
#pragma unroll
                    for (int r = 0; r < 16; ++r) st[kt][r] -= up;
            }
            float ps = 0.f;
#pragma unroll
            for (int kt = 0; kt < 2; ++kt)
#pragma unroll
                for (int r = 0; r < 16; ++r) { const float pv = ex2(st[kt][r]); st[kt][r] = pv; ps += pv; }
            lrow += ps;
            bf16x8 pf;
            __builtin_amdgcn_sched_barrier(0);
            ATT_PACK(pf, 0, 0);
            __builtin_amdgcn_s_setprio(1);
#pragma unroll
            for (int dt = 0; dt < 4; ++dt) ot[dt] = mfma32(vf0[dt], pf, ot[dt]);
            __builtin_amdgcn_s_setprio(0);
            ATT_LDV(vf0, 2);
            ATT_PACK(pf, 0, 8);
            __builtin_amdgcn_sched_barrier(0);
            __builtin_amdgcn_s_setprio(1);
#pragma unroll
            for (int dt = 0; dt < 4; ++dt) ot[dt] = mfma32(vf1[dt], pf, ot[dt]);
            __builtin_amdgcn_s_setprio(0);
            ATT_LDV(vf1, 3);
            ATT_PACK(pf, 1, 0);
            __builtin_amdgcn_sched_barrier(0);
            __builtin_amdgcn_s_setprio(1);
#pragma unroll
            for (int dt = 0; dt < 4; ++dt) ot[dt] = mfma32(vf0[dt], pf, ot[dt]);
            ATT_PACK(pf, 1, 8);
#pragma unroll
            for (int dt = 0; dt < 4; ++dt) ot[dt] = mfma32(vf1[dt], pf, ot[dt]);
            __builtin_amdgcn_s_setprio(0);
        }
        if (it + 1 < ntiles) ATT_STORE(buf ^ 1);
        __syncthreads();
    }
#undef ATT_LDV
#undef ATT_PACK
#undef ATT_LOAD
#undef ATT_STORE
    const float lt = lrow + __shfl_xor(lrow, 32);
    const float inv = 1.f / lt;
    LAS float* EX = (LAS float*)(lds + 71680) + (rg * 32 + ql) * 132;
    if (active && mp == 1) {
        const float sc = inv * lam;
#pragma unroll
        for (int dt = 0; dt < 4; ++dt)
#pragma unroll
            for (int g4 = 0; g4 < 4; ++g4) { f32x4 e; e[0] = ot[dt][4 * g4] * sc; e[1] = ot[dt][4 * g4 + 1] * sc; e[2] = ot[dt][4 * g4 + 2] * sc; e[3] = ot[dt][4 * g4 + 3] * sc; *(LAS f32x4*)(EX + dt * 32 + 8 * g4 + 4 * hh) = e; }
    }
    __syncthreads();
    if (active && mp == 0) {
        float ss = 0.f;
#pragma unroll
        for (int dt = 0; dt < 4; ++dt)
#pragma unroll
            for (int g4 = 0; g4 < 4; ++g4) { const f32x4 e = *(LAS f32x4*)(EX + dt * 32 + 8 * g4 + 4 * hh);
#pragma unroll
                for (int i = 0; i < 4; ++i) { const float o = ot[dt][4 * g4 + i] * inv - e[i]; ot[dt][4 * g4 + i] = o; ss += o * o; } }
        ss += __shfl_xor(ss, 32);
        const float rs = rsqrtf(ss * (1.f / 128.f) + EPS) * osc;
        const size_t row = row0q + rg * 32 + ql;
#pragma unroll
        for (int dt = 0; dt < 4; ++dt)
#pragma unroll
            for (int g4 = 0; g4 < 4; ++g4) { const int dv = dt * 32 + 8 * g4 + 4 * hh; const f32x4 w = *(const f32x4*)(subln + dv); const u32x2 z = *(const u32x2*)(ZB + row * 1024 + h * 128 + dv);
                u32x2 o; o[0] = pk2(ot[dt][4 * g4] * rs * w[0] * bflo(z[0]), ot[dt][4 * g4 + 1] * rs * w[1] * bfhi(z[0])); o[1] = pk2(ot[dt][4 * g4 + 2] * rs * w[2] * bflo(z[1]), ot[dt][4 * g4 + 3] * rs * w[3] * bfhi(z[1]));
                *(u32x2*)(AO + row * 1024 + h * 128 + dv) = o; }
    }
}

__device__ __forceinline__ void attn_phase(const Params& p, LAS unsigned char* lds, int j, int l) {
    int lane = threadIdx.x & 63; asm volatile("" : "+v"(lane));
    const int G = gridDim.x;
    const float* lv = p.attn_lambda + j * 256;
    const float s01 = wave_sum(lv[lane] * lv[64 + lane]), s23 = wave_sum(lv[128 + lane] * lv[192 + lane]);
    const float lam_init = 0.8f - 0.6f * expf(-0.3f * (float)l);
    const float lam = expf(s01) - expf(s23) + lam_init, osc = 1.f - lam_init;
    const bf16_t* QB = (const bf16_t*)(p.ws + WS_QB); const bf16_t* KB = (const bf16_t*)(p.ws + WS_KB); const bf16_t* VB = (const bf16_t*)(p.ws + WS_VB); const bf16_t* ZB = (const bf16_t*)(p.ws + WS_ZB);
    const bf16_t* KC = (const bf16_t*)(p.ws + WS_KC) + (size_t)j * 16 * KVS * 1024; const bf16_t* VC = (const bf16_t*)(p.ws + WS_VC) + (size_t)j * 16 * KVS * 1024;
    bf16_t* AO = (bf16_t*)(p.ws + WS_AO);
    const float* subln = p.attn_subln + j * 128;
    const bool bal = (G == 256);
    for (int item = blockIdx.x; item < 384; item += G) {
        if (item < 256) { const int b = item >> 3, h = item & 7;
#pragma unroll 1
            for (int qb = 0; qb < 17; ++qb) {
                int bb = b, hq = h, q = qb;
                if (qb == 16) { if (!(bal && item >= 128)) break; bb = (item - 128) >> 3; hq = (item - 128) & 7; q = 7; }
                else if (bal && item < 128 && qb == 7) continue;
                attn_unit(lds, QB, KB + (size_t)bb * 2048 * 1024, VB + (size_t)bb * 2048 * 1024, ZB, AO, subln, (size_t)bb * 2048 + q * 128, hq, 2 * q + 2, q * 128, 4, true, lam, osc);
            }
        } else { const int it = item - 256, b = it >> 3, h = it & 7;
            attn_unit(lds, QB, KC + (size_t)b * KVS * 1024, VC + (size_t)b * KVS * 1024, ZB, AO, subln, (size_t)MP + b * 64, h, 33, 2048, 2, false, lam, osc);
        }
    }
}

__global__ void __launch_bounds__(512, 2) mega_fwd(Params p) {
    extern __shared__ __attribute__((aligned(16))) unsigned char lds_raw[];
    LAS unsigned char* lds = (LAS unsigned char*)lds_raw;
    cg::grid_group grid = cg::this_grid();
    prologue(p, lds);
    grid.sync();
    bf16_t* XA = (bf16_t*)(p.ws + WS_XA); bf16_t* AO = (bf16_t*)(p.ws + WS_AO);
    float* SSQ = (float*)(p.ws + WS_SSQ); float* OSSQ = (float*)(p.ws + WS_OSSQ);
#pragma unroll 1
    for (int l = 0; l < 4; ++l) {
        const int j = l >> 1; const bool attn = (l & 1) != 0;
        {
            pg8::Gemm g{XA, (const bf16_t*)(p.ws + WS_WTIN) + (size_t)l * 4096 * 1024, MT, 4096, 1024};
            pg8::StaticOrder S; S.init(MT, 4096, (int)gridDim.x, (int)blockIdx.x);
            EpiIn E; E.mode = attn ? 1 : 0; E.j = j; E.ws = p.ws; E.outb = p.out; E.qnb = p.attn_q_norm; E.knb = p.attn_k_norm;
            pg8::gemm_phase<EpiIn, pg8::StaticOrder, false>(lds, g, S, E, nullptr);
        }
        grid.sync();
        if (attn) attn_phase(p, lds, j, l); else gla_phase(p, lds, j);
        grid.sync();
        {
            pg8::Gemm g{AO, (const bf16_t*)(p.ws + WS_WTOUT) + (size_t)l * 1024 * 1024, MT, 1024, 1024};
            pg8::StaticOrder S; S.init(MT, 1024, (int)gridDim.x, (int)blockIdx.x);
            EpiOut E; E.out = l == 3 ? p.out : nullptr; E.XA = XA; E.ssq = SSQ; E.ossq = attn ? nullptr : OSSQ;
            pg8::gemm_phase<EpiOut, pg8::StaticOrder, false>(lds, g, S, E, nullptr);
        }
        if (l < 3) grid.sync();
    }
}

extern "C" void kernel_launch(void* const* d_in, const int* in_sizes, int n_in, void* d_out, int out_size, void* d_ws, size_t ws_size, hipStream_t stream) {
    static int grid = 0;
    if (grid == 0) {
        if (n_in != 16 || ws_size < WS_END) { fprintf(stderr, "kernel_launch: unexpected n_in %d / ws_size %zu\n", n_in, ws_size); grid = -1; return; }
        int dev = 0, cus = 0, per_cu = 0;
        hipGetDevice(&dev); hipDeviceGetAttribute(&cus, hipDeviceAttributeMultiprocessorCount, dev);
        if (hipFuncSetAttribute((const void*)mega_fwd, hipFuncAttributeMaxDynamicSharedMemorySize, LDS_BYTES) != hipSuccess) fprintf(stderr, "kernel_launch: hipFuncSetAttribute failed\n");
        if (hipOccupancyMaxActiveBlocksPerMultiprocessor(&per_cu, (const void*)mega_fwd, 512, LDS_BYTES) != hipSuccess || per_cu < 1) { fprintf(stderr, "kernel_launch: occupancy query gave %d\n", per_cu); per_cu = 1; }
        (void)hipGetLastError();
        grid = cus * per_cu;
    }
    if (grid < 0) return;
    Params p{};
    p.x_prompt = (const float*)d_in[0]; p.x_sample = (const float*)d_in[1]; p.cache_k = (const float*)d_in[2]; p.cache_v = (const float*)d_in[3]; p.state_hgrn = (const float*)d_in[4];
    p.norm_w = (const float*)d_in[5]; p.hgrn_w_in = (const float*)d_in[6]; p.hgrn_lb_logits = (const float*)d_in[7]; p.hgrn_onorm_w = (const float*)d_in[8]; p.hgrn_w_out = (const float*)d_in[9];
    p.attn_w_in = (const float*)d_in[10]; p.attn_q_norm = (const float*)d_in[11]; p.attn_k_norm = (const float*)d_in[12]; p.attn_lambda = (const float*)d_in[13]; p.attn_subln = (const float*)d_in[14];
    p.attn_w_out = (const float*)d_in[15];
    p.out = (float*)d_out; p.ws = (unsigned char*)d_ws;
    void* args[] = {&p};
    hipError_t e = hipLaunchCooperativeKernel((const void*)mega_fwd, dim3(grid), dim3(512), args, LDS_BYTES, stream);
    if (e != hipSuccess) fprintf(stderr, "cooperative launch failed: %s (grid %d)\n", hipGetErrorString(e), grid);
}
```

```cpp
#include <hip/hip_runtime.h>
#include <hip/hip_cooperative_groups.h>
#include <cstdio>
#include <cstdint>
namespace cg = cooperative_groups;
namespace pg8 {
#define PG8_LAS __attribute__((address_space(3)))
typedef unsigned short bf16_t;
typedef short bf16x8 __attribute__((ext_vector_type(8)));
typedef float f32x4 __attribute__((ext_vector_type(4)));
typedef unsigned u32x4 __attribute__((ext_vector_type(4)));
constexpr int BM = 256, BK = 64, HALF = 128, HTB = HALF * BK * 2  , STAGE_BYTES = 8 * HTB, NXCD = 8, WGM = 8;

__host__ __device__ __forceinline__ int lds_byte(int r, int c) { const int st = (r >> 4) * 2 + (c >> 5), rr = r & 15, cc = c & 31, ob = rr * 64 + cc * 2; return st * 1024 + (ob ^ (((ob >> 9) & 1) << 5)); }
__host__ __device__ __forceinline__ void stage_rc(int b, int& R, int& C) { const int st = b / 1024, sb = b % 1024, swz = sb ^ (((sb >> 9) & 1) << 5); R = (st >> 1) * 16 + swz / 64; C = (st & 1) * 32 + (swz % 64) / 2; }
__host__ __device__ __forceinline__ int perm32(int rho) { const int n = rho >> 4, i = rho & 15; return 8 * (i >> 2) + 4 * n + (i & 3); }

struct Unit { int pm, pn; };
struct Gemm { const bf16_t* A; const bf16_t* Bt; int M, N, K; };

struct StaticOrder {
    int nM, nN, nwg, G, c;
    __host__ __device__ void init(int M, int N, int G_, int c_) { nM = M / BM; nN = N / BM; nwg = nM * nN; G = G_; c = c_; }
    __host__ __device__ bool next(int i, Unit& u) const {
        const long L = (long)i * G + c; if (L >= nwg) return false;
        int wgid = (int)L; { const int q = nwg / NXCD, r = nwg % NXCD, xcd = wgid % NXCD, off = wgid / NXCD; wgid = (xcd < r ? xcd * (q + 1) : r * (q + 1) + (xcd - r) * q) + off; }
        const int nig = WGM * nN, gid = wgid / nig, fm = gid * WGM, gsz = (nM - fm) < WGM ? (nM - fm) : WGM;
        u.pm = fm + ((wgid % nig) % gsz); u.pn = (wgid % nig) / gsz; return true;
    }
    __device__ __forceinline__ void a_ready(const Unit&) const {}
    __device__ __forceinline__ void done(const Unit&) const {}
};
__device__ __forceinline__ unsigned cvt_pk_bf16(float lo, float hi) { unsigned r; asm volatile("v_cvt_pk_bf16_f32 %0, %1, %2" : "=v"(r) : "v"(lo), "v"(hi)); return r; }
template <class Epi, class Sched, bool STAMP = false>
__device__ __forceinline__ void gemm_phase(PG8_LAS unsigned char* lds, const Gemm g, const Sched& S, const Epi& E, unsigned long long* stamps) {
    int tid_l = threadIdx.x; asm volatile("" : "+v"(tid_l));
    const int tid = tid_l, wid = __builtin_amdgcn_readfirstlane(tid >> 6), lane = tid & 63, wr = wid >> 2, wc = wid & 3, fr = lane & 15, fq = lane >> 4;
    const int K = g.K, nt = K / BK;
    int ts_lo = 0, ts_hi = 0, nts = 0; const unsigned long long rt_entry = STAMP ? (unsigned long long)wall_clock64() : 0ull;
#define PG8_STAMP() do { if (STAMP && wid == 0 && nts < 64) { const unsigned long long _c = (unsigned long long)clock64(); \
        ts_lo = (lane == nts) ? (int)(unsigned)_c : ts_lo; ts_hi = (lane == nts) ? (int)(unsigned)(_c >> 32) : ts_hi; ++nts; } } while (0)
    PG8_STAMP();
    unsigned voffA[2], voffB[2];
#pragma unroll
    for (int i = 0; i < 2; ++i) { int R, C; stage_rc(tid * 16 + i * 8192, R, C); const int Rb = Epi::PERM ? ((R & ~31) + perm32(R & 31)) : R;
        voffA[i] = (unsigned)(R * K + C) * 2u; voffB[i] = (unsigned)(Rb * K + C) * 2u; }
    const size_t kstep = (size_t)(BK * 2);
    const size_t hstep = (size_t)HALF * K * 2;
    const size_t tstep = 2 * hstep;
    const unsigned ldsw = (unsigned)wid * 1024u;
    const int aoff = lds_byte(wr * 64 + fr, fq * 8), boff = lds_byte(wc * 32 + fr, fq * 8);
#define PG8_SA(b, h) (((b) * 2 + (h)) * HTB)
#define PG8_SB(b, h) ((4 + (b) * 2 + (h)) * HTB)
#define PG8_STAGE(bufoff, gbase, voff) do { _Pragma("unroll") for (int _i = 0; _i < 2; ++_i) \
        __builtin_amdgcn_global_load_lds((const unsigned*)((const char*)(gbase) + (voff)[_i]), (PG8_LAS unsigned*)(lds + (bufoff) + ldsw + _i * 8192), 16, 0, 0); } while (0)
#define PG8_LDA(dst, b, h) do { _Pragma("unroll") for (int m = 0; m < 4; ++m) _Pragma("unroll") for (int k = 0; k < 2; ++k) dst[m][k] = *(const PG8_LAS bf16x8*)(lds + PG8_SA(b, h) + aoff + m * 2048 + k * 1024); } while (0)
#define PG8_LDB(dst, b, h) do { _Pragma("unroll") for (int n = 0; n < 2; ++n) _Pragma("unroll") for (int k = 0; k < 2; ++k) dst[n][k] = *(const PG8_LAS bf16x8*)(lds + PG8_SB(b, h) + boff + n * 2048 + k * 1024); } while (0)
#define PG8_MMA(ai, bj, At, Bt) do { __builtin_amdgcn_s_setprio(1); _Pragma("unroll") for (int m = 0; m < 4; ++m) _Pragma("unroll") for (int n = 0; n < 2; ++n) _Pragma("unroll") for (int k = 0; k < 2; ++k) \
        acc[ai][bj][m][n] = __builtin_amdgcn_mfma_f32_16x16x32_bf16(Bt[n][k], At[m][k], acc[ai][bj][m][n], 0, 0, 0); __builtin_amdgcn_s_setprio(0); } while (0)
#define PG8_WAIT_V(n) asm volatile("s_waitcnt vmcnt(" #n ")" ::: "memory")
#define PG8_WAIT_L(n) asm volatile("s_waitcnt lgkmcnt(" #n ")" ::: "memory")
#define PG8_BAR __builtin_amdgcn_s_barrier()
#define PG8_SCHED __builtin_amdgcn_sched_barrier(0)
    Unit cur, nxt; int ui = 0;
    if (!S.next(0, cur)) return;
    f32x4 acc[2][2][4][2];
#pragma unroll
    for (int a = 0; a < 2; ++a)
#pragma unroll
        for (int b = 0; b < 2; ++b)
#pragma unroll
            for (int m = 0; m < 4; ++m)
#pragma unroll
                for (int n = 0; n < 2; ++n) acc[a][b][m][n] = (f32x4){0.f, 0.f, 0.f, 0.f};
    bf16x8 At[4][2], B0[2][2], B1[2][2];
    const char* cA = (const char*)g.A + (size_t)cur.pm * tstep; const char* cB = (const char*)g.Bt + (size_t)cur.pn * tstep;
    S.a_ready(cur);
    PG8_STAGE(PG8_SB(0, 0), cB, voffB); PG8_STAGE(PG8_SA(0, 0), cA, voffA); PG8_STAGE(PG8_SB(0, 1), cB + hstep, voffB); PG8_STAGE(PG8_SA(0, 1), cA + hstep, voffA);
    if (wr == 1) PG8_BAR;
    PG8_WAIT_V(4); PG8_BAR;
    PG8_STAGE(PG8_SB(1, 0), cB + kstep, voffB); PG8_STAGE(PG8_SA(1, 0), cA + kstep, voffA); PG8_STAGE(PG8_SB(1, 1), cB + hstep + kstep, voffB);
    PG8_WAIT_V(6); PG8_BAR;
    PG8_STAMP();
    for (;;) {
        const bool has_next = S.next(ui + 1, nxt);
        const char* nA = has_next ? (const char*)g.A + (size_t)nxt.pm * tstep : cA; const char* nB = has_next ? (const char*)g.Bt + (size_t)nxt.pn * tstep : cB;
        for (int t = 0; t < nt; t += 2) {
            const bool last = (t == nt - 2);
            const char* a1 = cA + (size_t)(t + 1) * kstep;
            const char* a2 = last ? nA : cA + (size_t)(t + 2) * kstep; const char* b2 = last ? nB : cB + (size_t)(t + 2) * kstep;
            const char* a3 = a2 + kstep; const char* b3 = b2 + kstep;
            if (last && has_next) S.a_ready(nxt);
            PG8_LDB(B0, 0, 0); PG8_SCHED; PG8_LDA(At, 0, 0); PG8_STAGE(PG8_SA(1, 1), a1 + hstep, voffA);
            PG8_WAIT_L(8); PG8_BAR; PG8_WAIT_L(0); PG8_MMA(0, 0, At, B0); PG8_BAR; PG8_SCHED;
            PG8_LDB(B1, 0, 1); PG8_STAGE(PG8_SB(0, 0), b2, voffB);
            PG8_BAR; PG8_WAIT_L(0); PG8_MMA(0, 1, At, B1); PG8_BAR;
            PG8_LDA(At, 0, 1); PG8_STAGE(PG8_SA(0, 0), a2, voffA);
            PG8_BAR; PG8_WAIT_L(0); PG8_MMA(1, 0, At, B0); PG8_BAR; PG8_SCHED;
            PG8_STAGE(PG8_SB(0, 1), b2 + hstep, voffB);
            PG8_WAIT_V(6); PG8_BAR; PG8_MMA(1, 1, At, B1); PG8_BAR;
            PG8_LDB(B0, 1, 0); PG8_SCHED; PG8_LDA(At, 1, 0); PG8_STAGE(PG8_SA(0, 1), a2 + hstep, voffA);
            PG8_WAIT_L(8); PG8_BAR; PG8_WAIT_L(0); PG8_MMA(0, 0, At, B0); PG8_BAR; PG8_SCHED;
            PG8_LDB(B1, 1, 1); PG8_STAGE(PG8_SB(1, 0), b3, voffB);
            PG8_BAR; PG8_WAIT_L(0); PG8_MMA(0, 1, At, B1); PG8_BAR;
            PG8_LDA(At, 1, 1); PG8_STAGE(PG8_SA(1, 0), a3, voffA);
            PG8_BAR; PG8_WAIT_L(0); PG8_MMA(1, 0, At, B0); PG8_BAR; PG8_SCHED;
            PG8_STAGE(PG8_SB(1, 1), b3 + hstep, voffB);
            PG8_WAIT_V(6); PG8_BAR; PG8_MMA(1, 1, At, B1); PG8_BAR;
        }
        PG8_STAMP();
        if constexpr (!Epi::AFTER_DRAIN) { E(acc, cur, wr, wc, fr, fq); S.done(cur); }
        PG8_STAMP();
        if (!has_next) break;
#pragma unroll
        for (int a = 0; a < 2; ++a)
#pragma unroll
            for (int b = 0; b < 2; ++b)
#pragma unroll
                for (int m = 0; m < 4; ++m)
#pragma unroll
                    for (int n = 0; n < 2; ++n) acc[a][b][m][n] = (f32x4){0.f, 0.f, 0.f, 0.f};
        cur = nxt; cA = nA; cB = nB; ++ui;
    }
    PG8_WAIT_V(0);
    if (wr == 0) PG8_BAR;
    PG8_BAR;
    if constexpr (Epi::AFTER_DRAIN) { E.fused(acc, cur, wr, wc, fr, fq, lds, wid, lane); S.done(cur); }
    PG8_STAMP();
    if (STAMP && wid == 0) { stamps[lane] = lane < nts ? (((unsigned long long)(unsigned)ts_hi << 32) | (unsigned)ts_lo) : 0ull;
        if (lane == 62) stamps[62] = rt_entry; if (lane == 63) stamps[63] = (unsigned long long)wall_clock64(); }
#undef PG8_STAMP
#undef PG8_SA
#undef PG8_SB
#undef PG8_STAGE
#undef PG8_LDA
#undef PG8_LDB
#undef PG8_MMA
#undef PG8_WAIT_V
#undef PG8_WAIT_L
#undef PG8_BAR
#undef PG8_SCHED
}
}

#define LAS __attribute__((address_space(3)))
using pg8::bf16_t; using pg8::bf16x8; using pg8::f32x4; using pg8::u32x4;
typedef short bf16x4 __attribute__((ext_vector_type(4)));
typedef float f32x16 __attribute__((ext_vector_type(16)));
typedef unsigned u32x2 __attribute__((ext_vector_type(2)));
typedef short v4i16_t __attribute__((ext_vector_type(4)));

constexpr int DM = 1024, MP = 65536, MS = 1024, MT = MP + MS, KVS = 2112;
constexpr float EPS = 1e-6f, LOG2E = 1.4426950408889634f;
constexpr size_t O_YP = 0, O_YS = 67108864, O_KP = 68157440, O_VP = 202375168, O_KS = 336592896, O_VS = 338690048, O_SP = 340787200, O_SS = 349175808;
constexpr size_t MiB = 1u << 20;
constexpr size_t WS_WTIN = 0, WS_WTOUT = 32 * MiB, WS_LB = 40 * MiB, WS_SSQ = 41 * MiB, WS_OSSQ = 46 * MiB, WS_XA = 64 * MiB, WS_QB = 200 * MiB, WS_KB = 336 * MiB,
                 WS_VB = 472 * MiB, WS_ZB = 608 * MiB, WS_AO = 744 * MiB, WS_KC = 880 * MiB, WS_VC = 1016 * MiB, WS_END = 1152 * MiB;
constexpr int LDS_BYTES = 147456;

struct Params {
    const float *x_prompt, *x_sample, *cache_k, *cache_v, *state_hgrn, *norm_w, *hgrn_w_in, *hgrn_lb_logits, *hgrn_onorm_w, *hgrn_w_out,
                *attn_w_in, *attn_q_norm, *attn_k_norm, *attn_lambda, *attn_subln, *attn_w_out;
    float* out; unsigned char* ws;
};

__device__ __forceinline__ unsigned pk2(float lo, float hi) { typedef float f2 __attribute__((ext_vector_type(2))); typedef __bf16 b2 __attribute__((ext_vector_type(2)));
    f2 v = {lo, hi}; b2 b = __builtin_convertvector(v, b2); return __builtin_bit_cast(unsigned, b); }
__device__ __forceinline__ float bflo(unsigned u) { return __uint_as_float(u << 16); }
__device__ __forceinline__ float bfhi(unsigned u) { return __uint_as_float(u & 0xffff0000u); }
__device__ __forceinline__ float wave_sum(float v) {
#pragma unroll
    for (int o = 32; o > 0; o >>= 1) v += __shfl_xor(v, o);
    return v; }
__device__ __forceinline__ float ex2(float x) { return __builtin_amdgcn_exp2f(x); }
__device__ __forceinline__ u32x4 pack8(f32x4 a, f32x4 b) { u32x4 r; r[0] = pk2(a[0], a[1]); r[1] = pk2(a[2], a[3]); r[2] = pk2(b[0], b[1]); r[3] = pk2(b[2], b[3]); return r; }

struct EpiIn {
    static constexpr bool PERM = true, AFTER_DRAIN = false;
    int mode, j;
    unsigned char* ws; float* outb; const float* qnb; const float* knb;
    __device__ __forceinline__ void operator()(const f32x4 (&acc)[2][2][4][2], const pg8::Unit& u, int wr, int wc, int fr, int fq) const {
        const float* ssq = (const float*)(ws + WS_SSQ); const float* lb = (const float*)(ws + WS_LB) + j * 1024; const float* qn = qnb + j * 64; const float* kn = knb + j * 64;
        bf16_t* QB = (bf16_t*)(ws + WS_QB); bf16_t* KB = (bf16_t*)(ws + WS_KB); bf16_t* VB = (bf16_t*)(ws + WS_VB); bf16_t* ZB = (bf16_t*)(ws + WS_ZB);
        bf16_t* KC = (bf16_t*)(ws + WS_KC) + (size_t)j * 16 * KVS * 1024; bf16_t* VC = (bf16_t*)(ws + WS_VC) + (size_t)j * 16 * KVS * 1024;
        float* okp = outb + O_KP + (size_t)j * MP * 1024; float* ovp = outb + O_VP + (size_t)j * MP * 1024; float* oks = outb + O_KS + (size_t)j * MS * 1024; float* ovs = outb + O_VS + (size_t)j * MS * 1024;
        const int region = u.pn >> 2, pg = u.pn & 3;
        const int cb = pg * 256 + wc * 64 + 8 * fq;
        const bool samp = u.pm >= 256;
        float rsv[2][4];
#pragma unroll
        for (int ai = 0; ai < 2; ++ai)
#pragma unroll
            for (int m = 0; m < 4; ++m) { const int row = u.pm * 256 + ai * 128 + wr * 64 + m * 16 + fr;
                const f32x4 s4 = *(const f32x4*)(ssq + (size_t)row * 16 + 4 * fq); rsv[ai][m] = (s4[0] + s4[1]) + (s4[2] + s4[3]); }
#pragma unroll
        for (int ai = 0; ai < 2; ++ai)
#pragma unroll
            for (int m = 0; m < 4; ++m) { float t = rsv[ai][m]; t += __shfl_xor(t, 16); t += __shfl_xor(t, 32); rsv[ai][m] = rsqrtf(t * (1.f / 1024.f) + EPS); }
        f32x4 wq[2][2];
        { const float* wb = mode == 0 ? lb + cb : (region == 0 ? qn : kn) + 8 * fq;
#pragma unroll
          for (int bj = 0; bj < 2; ++bj)
#pragma unroll
              for (int n = 0; n < 2; ++n) wq[bj][n] = *(const f32x4*)(wb + 32 * bj + 4 * n); }
#pragma unroll
        for (int ai = 0; ai < 2; ++ai)
#pragma unroll
            for (int m = 0; m < 4; ++m) {
                const int row = u.pm * 256 + ai * 128 + wr * 64 + m * 16 + fr;
                const float rs = rsv[ai][m];
                f32x4 v[2][2];
#pragma unroll
                for (int bj = 0; bj < 2; ++bj)
#pragma unroll
                    for (int n = 0; n < 2; ++n) v[bj][n] = acc[ai][bj][m][n] * rs;
                if (region == 3) {
#pragma unroll
                    for (int bj = 0; bj < 2; ++bj) {
#pragma unroll
                        for (int n = 0; n < 2; ++n)
#pragma unroll
                            for (int j = 0; j < 4; ++j) { const float x = v[bj][n][j]; v[bj][n][j] = x * __builtin_amdgcn_rcpf(1.f + ex2(-LOG2E * x)); }
                        *(u32x4*)(ZB + (size_t)row * 1024 + cb + 32 * bj) = pack8(v[bj][0], v[bj][1]);
                    }
                } else if (mode == 0) {
                    if (region == 0) {
#pragma unroll
                        for (int bj = 0; bj < 2; ++bj) *(u32x4*)(QB + (size_t)row * 1024 + cb + 32 * bj) = pack8(v[bj][0] * 0.08838834764831845f, v[bj][1] * 0.08838834764831845f);
                    } else if (region == 1) {
#pragma unroll
                        for (int bj = 0; bj < 2; ++bj) {
#pragma unroll
                            for (int n = 0; n < 2; ++n) { const f32x4 l4 = wq[bj][n];
#pragma unroll
                                for (int j = 0; j < 4; ++j) { const float sg = __builtin_amdgcn_rcpf(1.f + ex2(-LOG2E * v[bj][n][j])); const float f = l4[j] + (1.f - l4[j]) * sg; v[bj][n][j] = __builtin_amdgcn_logf(f); } }
                            *(u32x4*)(KB + (size_t)row * 1024 + cb + 32 * bj) = pack8(v[bj][0], v[bj][1]);
                        }
                    } else {
#pragma unroll
                        for (int bj = 0; bj < 2; ++bj) *(u32x4*)(VB + (size_t)row * 1024 + cb + 32 * bj) = pack8(v[bj][0], v[bj][1]);
                    }
                } else {
                    const int srow = row - MP;
                    const size_t crow = samp ? (size_t)(srow >> 6) * KVS + 2048 + (srow & 63) : 0;
                    if (region <= 1) {
                        float ss = 0.f;
#pragma unroll
                        for (int bj = 0; bj < 2; ++bj)
#pragma unroll
                            for (int n = 0; n < 2; ++n)
#pragma unroll
                                for (int j = 0; j < 4; ++j) ss += v[bj][n][j] * v[bj][n][j];
                        ss += __shfl_xor(ss, 16); ss += __shfl_xor(ss, 32);
                        float r2 = rsqrtf(ss * (1.f / 64.f) + EPS);
                        if (region == 0) r2 *= 0.125f * LOG2E;
#pragma unroll
                        for (int bj = 0; bj < 2; ++bj)
#pragma unroll
                            for (int n = 0; n < 2; ++n) v[bj][n] = v[bj][n] * wq[bj][n] * r2;
                        if (region == 0) {
#pragma unroll
                            for (int bj = 0; bj < 2; ++bj) *(u32x4*)(QB + (size_t)row * 1024 + cb + 32 * bj) = pack8(v[bj][0], v[bj][1]);
                        } else {
                            float* of = samp ? oks + (size_t)srow * 1024 : okp + (size_t)row * 1024;
                            bf16_t* ob = samp ? KC + crow * 1024 : KB + (size_t)row * 1024;
#pragma unroll
                            for (int bj = 0; bj < 2; ++bj) { __builtin_nontemporal_store(v[bj][0], (f32x4*)(of + cb + 32 * bj)); __builtin_nontemporal_store(v[bj][1], (f32x4*)(of + cb + 32 * bj + 4)); *(u32x4*)(ob + cb + 32 * bj) = pack8(v[bj][0], v[bj][1]); }
                        }
                    } else {
                        float* of = samp ? ovs + (size_t)srow * 1024 : ovp + (size_t)row * 1024;
                        bf16_t* ob = samp ? VC + crow * 1024 : VB + (size_t)row * 1024;
#pragma unroll
                        for (int bj = 0; bj < 2; ++bj) { __builtin_nontemporal_store(v[bj][0], (f32x4*)(of + cb + 32 * bj)); __builtin_nontemporal_store(v[bj][1], (f32x4*)(of + cb + 32 * bj + 4)); *(u32x4*)(ob + cb + 32 * bj) = pack8(v[bj][0], v[bj][1]); }
                    }
                }
            }
    }
};

struct EpiOut {
    static constexpr bool PERM = true, AFTER_DRAIN = false;
    float* out;
    bf16_t* XA;
    float* ssq;
    const float* ossq;
    __device__ __forceinline__ void operator()(const f32x4 (&acc)[2][2][4][2], const pg8::Unit& u, int wr, int wc, int fr, int fq) const {
        const int cb = u.pn * 256 + wc * 32 + 8 * fq;
        float rsv[8];
        if (ossq) {
#pragma unroll
            for (int r = 0; r < 8; ++r) { const int row = u.pm * 256 + (r >> 2) * 128 + wr * 64 + (r & 3) * 16 + fr;
                const f32x4 s4 = *(const f32x4*)(ossq + (size_t)row * 8 + 4 * (fq & 1)); rsv[r] = (s4[0] + s4[1]) + (s4[2] + s4[3]); }
#pragma unroll
            for (int r = 0; r < 8; ++r) { float t = rsv[r]; t += __shfl_xor(t, 16); rsv[r] = rsqrtf(t * (1.f / 1024.f) + EPS); }
        } else {
#pragma unroll
            for (int r = 0; r < 8; ++r) rsv[r] = 1.f;
        }
        u32x4 xq[4][2];
#pragma unroll
        for (int r = 0; r < 3; ++r) { const int row = u.pm * 256 + (r >> 2) * 128 + wr * 64 + (r & 3) * 16 + fr;
#pragma unroll
            for (int bj = 0; bj < 2; ++bj) xq[r][bj] = *(const u32x4*)(XA + (size_t)row * 1024 + cb + 128 * bj); }
#pragma unroll
        for (int r = 0; r < 8; ++r) {
            const int ai = r >> 2, m = r & 3;
            const int row = u.pm * 256 + ai * 128 + wr * 64 + m * 16 + fr;
            if (r + 3 < 8) { const int rn = r + 3, rown = u.pm * 256 + (rn >> 2) * 128 + wr * 64 + (rn & 3) * 16 + fr;
#pragma unroll
                for (int bj = 0; bj < 2; ++bj) xq[rn & 3][bj] = *(const u32x4*)(XA + (size_t)rown * 1024 + cb + 128 * bj); }
            const u32x4* xc = xq[r & 3];
            const float rs = rsv[r];
            float part = 0.f;
#pragma unroll
            for (int bj = 0; bj < 2; ++bj) {
                const int c = cb + 128 * bj;
                f32x4 x0, x1; x0[0] = bflo(xc[bj][0]); x0[1] = bfhi(xc[bj][0]); x0[2] = bflo(xc[bj][1]); x0[3] = bfhi(xc[bj][1]); x1[0] = bflo(xc[bj][2]); x1[1] = bfhi(xc[bj][2]); x1[2] = bflo(xc[bj][3]); x1[3] = bfhi(xc[bj][3]);
                const f32x4 y0 = x0 + acc[ai][bj][m][0] * rs, y1 = x1 + acc[ai][bj][m][1] * rs;
                if (out) { __builtin_nontemporal_store(y0, (f32x4*)(out + (size_t)row * 1024 + c)); __builtin_nontemporal_store(y1, (f32x4*)(out + (size_t)row * 1024 + c + 4)); }
                *(u32x4*)(XA + (size_t)row * 1024 + c) = pack8(y0, y1);
#pragma unroll
                for (int j = 0; j < 4; ++j) part += y0[j] * y0[j] + y1[j] * y1[j];
            }
            part += __shfl_xor(part, 16); part += __shfl_xor(part, 32);
            if (fq == 0) ssq[(size_t)row * 16 + u.pn * 4 + wc] = part;
        }
    }
};

__device__ __forceinline__ void phase_skew(int k) {
    const unsigned long long t0 = __builtin_amdgcn_s_memrealtime(); while (__builtin_amdgcn_s_memrealtime() - t0 < (unsigned long long)(k * 600)) __builtin_amdgcn_s_sleep(32);
}

__device__ __forceinline__ void prologue(const Params& p, LAS unsigned char* lds) {
    int tid = threadIdx.x; asm volatile("" : "+v"(tid));
    const int G = gridDim.x, bx = blockIdx.x, wave = tid >> 6, lane = tid & 63;
    LAS float* ts = (LAS float*)lds;
    bf16_t* wtin = (bf16_t*)(p.ws + WS_WTIN); bf16_t* wtout = (bf16_t*)(p.ws + WS_WTOUT);
    for (int tile = bx; tile < 5120; tile += G) {
        const float* W; bf16_t* WT; int N, ntile, ktile; const float* nw = nullptr; bool perm;
        if (tile < 4096) { const int l = tile >> 10, t = tile & 1023; ntile = t >> 3; ktile = t & 7; N = 4096; perm = true;
            W = ((l & 1) ? p.attn_w_in : p.hgrn_w_in) + (size_t)(l >> 1) * 1024 * 4096; WT = wtin + (size_t)l * 4096 * 1024; nw = p.norm_w + l * 1024; }
        else { const int t2 = tile - 4096, l = t2 >> 8, t = t2 & 255; ntile = t >> 3; ktile = t & 7; N = 1024; perm = false;
            W = ((l & 1) ? p.attn_w_out : p.hgrn_w_out) + (size_t)(l >> 1) * 1024 * 1024; WT = wtout + (size_t)l * 1024 * 1024; }
        const int vcol0 = ntile * 32, k0 = ktile * 128;
        int real0 = vcol0;
        if (perm) { const int region = vcol0 >> 10, rv = vcol0 & 1023, pg = rv >> 8, rem = rv & 255, bj = rem >> 7, wc = (rem & 127) >> 5; real0 = region * 1024 + pg * 256 + wc * 64 + bj * 32; }
#pragma unroll
        for (int i = 0; i < 2; ++i) { const int k = (tid >> 3) + 64 * i, c4 = (tid & 7) * 4;
            const f32x4 v = *(const f32x4*)(W + (size_t)(k0 + k) * N + real0 + c4); const float s = nw ? nw[k0 + k] : 1.f;
#pragma unroll
            for (int e = 0; e < 4; ++e) ts[k * 33 + c4 + e] = v[e] * s; }
        __syncthreads();
        { const int n = tid >> 4, ks = (tid & 15) * 8; f32x4 a, b;
#pragma unroll
            for (int e = 0; e < 4; ++e) { a[e] = ts[(ks + e) * 33 + n]; b[e] = ts[(ks + 4 + e) * 33 + n]; }
            *(u32x4*)(WT + (size_t)(vcol0 + n) * 1024 + k0 + ks) = pack8(a, b); }
        __syncthreads();
    }
    bf16_t* XA = (bf16_t*)(p.ws + WS_XA); float* SSQ = (float*)(p.ws + WS_SSQ);
    for (int row = bx * 8 + wave; row < MT; row += G * 8) {
        const float* xr = row < MP ? p.x_prompt + (size_t)row * 1024 : p.x_sample + (size_t)(row - MP) * 1024;
        float ss = 0.f;
#pragma unroll
        for (int i = 0; i < 4; ++i) { const f32x4 v = *(const f32x4*)(xr + (lane + 64 * i) * 4); ss += v[0] * v[0] + v[1] * v[1] + v[2] * v[2] + v[3] * v[3];
            u32x2 o; o[0] = pk2(v[0], v[1]); o[1] = pk2(v[2], v[3]); *(u32x2*)(XA + (size_t)row * 1024 + (lane + 64 * i) * 4) = o; }
        ss = wave_sum(ss);
        if (lane < 16) SSQ[(size_t)row * 16 + lane] = lane == 0 ? ss : 0.f;
    }
    { bf16_t* KC = (bf16_t*)(p.ws + WS_KC); bf16_t* VC = (bf16_t*)(p.ws + WS_VC);
      const size_t n8 = (size_t)2 * 16 * 2048 * 1024 / 8;
      for (size_t i0 = (size_t)bx * 2048 + tid; i0 < 2 * n8; i0 += (size_t)G * 2048) {
          f32x4 va[4], vb[4]; bf16_t* dst[4];
#pragma unroll
          for (int q = 0; q < 4; ++q) { const size_t i = i0 + 512 * q; const bool wh = i >= n8; const size_t e = (wh ? i - n8 : i) * 8; const size_t jb = e >> 21, rem = e & ((1u << 21) - 1);
              const float* src = (wh ? p.cache_v : p.cache_k) + e; dst[q] = (wh ? VC : KC) + jb * ((size_t)KVS * 1024) + rem;
              va[q] = __builtin_nontemporal_load((const f32x4*)src); vb[q] = __builtin_nontemporal_load((const f32x4*)src + 1); }
#pragma unroll
          for (int q = 0; q < 4; ++q) *(u32x4*)dst[q] = pack8(va[q], vb[q]);
      } }
    if (bx == 0) { float* LB = (float*)(p.ws + WS_LB);
        for (int c = tid; c < 1024; c += 512) { const float l0 = p.hgrn_lb_logits[c], l1 = p.hgrn_lb_logits[1024 + c]; LB[c] = 0.f; LB[1024 + c] = 1.f / (1.f + expf(l0 - l1)); } }
}

__device__ __forceinline__ f32x4 mfma16(bf16x4 a, bf16x4 b, f32x4 c) { return __builtin_amdgcn_mfma_f32_16x16x16bf16_1k(a, b, c, 0, 0, 0); }
__device__ __forceinline__ bf16x4 pack4(f32x4 a) { u32x2 r; r[0] = pk2(a[0], a[1]); r[1] = pk2(a[2], a[3]); return __builtin_bit_cast(bf16x4, r); }

__device__ __forceinline__ void gla_phase(const Params& p, LAS unsigned char* lds, int j) {
    int tid = threadIdx.x; asm volatile("" : "+v"(tid));
    const int lane = tid & 63, wave = __builtin_amdgcn_readfirstlane(tid >> 6), G = gridDim.x;
    LAS unsigned char* QH = lds; LAS unsigned char* KH = lds + 17408; LAS unsigned char* KT = lds + 34816; LAS unsigned char* VS = lds + 55296;
    LAS float* OB = (LAS float*)(lds + 72704); LAS float* DL = (LAS float*)(lds + 106496);
    const bf16_t* QB = (const bf16_t*)(p.ws + WS_QB); const bf16_t* GB = (const bf16_t*)(p.ws + WS_KB); const bf16_t* VB = (const bf16_t*)(p.ws + WS_VB); const bf16_t* ZB = (const bf16_t*)(p.ws + WS_ZB);
    bf16_t* AO = (bf16_t*)(p.ws + WS_AO); float* OSSQ = (float*)(p.ws + WS_OSSQ);
    for (int item = blockIdx.x; item < 384; item += G) {
        int lane_l = lane; asm volatile("" : "+v"(lane_l));
        const int v = lane_l & 15, kq = lane_l >> 4;
        const int tv = (wave - 4) * 64 + lane_l;
        int b, h, T; size_t row0; const float* S0; float* Sout;
        if (item < 256) { b = item >> 3; h = item & 7; T = 2048; row0 = (size_t)b * 2048; S0 = nullptr; Sout = p.out + O_SP + ((size_t)(j * 32 + b) * 8 + h) * 16384; }
        else { const int it = item - 256; b = it >> 3; h = it & 7; T = 64; row0 = (size_t)MP + b * 64; S0 = p.state_hgrn + ((size_t)(j * 16 + b) * 8 + h) * 16384; Sout = p.out + O_SS + ((size_t)(j * 16 + b) * 8 + h) * 16384; }
        f32x4 S[8];
#pragma unroll
        for (int i = 0; i < 8; ++i) S[i] = (f32x4){0.f, 0.f, 0.f, 0.f};
        if (S0) {
            const float* sp = S0 + (4 * kq) * 128 + 16 * wave + v;
#pragma unroll
            for (int i = 0; i < 8; ++i)
#pragma unroll
                for (int jj = 0; jj < 4; ++jj) S[i][jj] = sp[(16 * i + jj) * 128];
        }
        const int nsteps = T >> 6;
        unsigned rq[16], rg[16]; u32x4 rv[4], rz[4]; f32x4 ow0, ow1;
        const size_t hb = (size_t)h * 128;
        if (wave < 4) {
#pragma unroll
            for (int t = 0; t < 16; ++t) { const size_t r = row0 + wave * 16 + t; rq[t] = *(const unsigned*)(QB + r * 1024 + hb + 2 * lane); rg[t] = *(const unsigned*)(GB + r * 1024 + hb + 2 * lane); }
        } else {
#pragma unroll
            for (int i = 0; i < 4; ++i) { const int idx = tv + 256 * i; rv[i] = *(const u32x4*)(VB + (row0 + (idx >> 4)) * 1024 + hb + (idx & 15) * 8); }
            ow0 = *(const f32x4*)(p.hgrn_onorm_w + j * 1024 + hb + (tv & 15) * 8); ow1 = *(const f32x4*)(p.hgrn_onorm_w + j * 1024 + hb + (tv & 15) * 8 + 4);
        }
        for (int s = 0; s <= nsteps; ++s) {
            if (wave < 4) {
                if (s < nsteps) {
                    float e0 = 1.f, e1 = 1.f;
#pragma unroll
                    for (int t = 0; t < 16; ++t) {
                        const unsigned q2 = rq[t], g2 = rg[t];
                        const float fa = ex2(bflo(g2)), fb = ex2(bfhi(g2));
                        e0 *= fa; e1 *= fb;
                        const float qa = bflo(q2) * e0, qb = bfhi(q2) * e1;
                        const float ka = (1.f - fa) * __builtin_amdgcn_rcpf(fmaxf(e0, 7.5e-37f)), kb = (1.f - fb) * __builtin_amdgcn_rcpf(fmaxf(e1, 7.5e-37f));
                        const int row = wave * 16 + t;
                        *(LAS unsigned*)(QH + row * 272 + lane * 4) = pk2(qa, qb);
                        const unsigned kk = pk2(ka, kb);
                        *(LAS unsigned*)(KH + row * 272 + lane * 4) = kk;
                        *(LAS unsigned short*)(KT + (wave * 128 + 2 * lane) * 40 + t * 2) = (unsigned short)(kk & 0xffffu);
                        *(LAS unsigned short*)(KT + (wave * 128 + 2 * lane + 1) * 40 + t * 2) = (unsigned short)(kk >> 16);
                    }
                    DL[wave * 128 + 2 * lane] = e0; DL[wave * 128 + 2 * lane + 1] = e1;
                    if (s + 1 < nsteps) {
#pragma unroll
                        for (int t = 0; t < 16; ++t) { const size_t r = row0 + (s + 1) * 64 + wave * 16 + t; rq[t] = *(const unsigned*)(QB + r * 1024 + hb + 2 * lane); rg[t] = *(const unsigned*)(GB + r * 1024 + hb + 2 * lane); }
                    }
                }
            } else {
                if (s > 0) {
#pragma unroll
                    for (int i = 0; i < 4; ++i) { const int idx = tv + 256 * i, r = idx >> 4, sg = idx & 15;
                        const f32x4 o0 = *(LAS f32x4*)(OB + r * 132 + sg * 8), o1 = *(LAS f32x4*)(OB + r * 132 + sg * 8 + 4);
                        const u32x4 z = rz[i];
                        f32x4 a0, a1;
                        a0[0] = o0[0] * ow0[0] * bflo(z[0]); a0[1] = o0[1] * ow0[1] * bfhi(z[0]); a0[2] = o0[2] * ow0[2] * bflo(z[1]); a0[3] = o0[3] * ow0[3] * bfhi(z[1]);
                        a1[0] = o1[0] * ow1[0] * bflo(z[2]); a1[1] = o1[1] * ow1[1] * bfhi(z[2]); a1[2] = o1[2] * ow1[2] * bflo(z[3]); a1[3] = o1[3] * ow1[3] * bfhi(z[3]);
                        const size_t grow = row0 + (size_t)(s - 1) * 64 + r;
                        *(u32x4*)(AO + grow * 1024 + hb + sg * 8) = pack8(a0, a1);
                        float ss = o0[0] * o0[0] + o0[1] * o0[1] + o0[2] * o0[2] + o0[3] * o0[3] + o1[0] * o1[0] + o1[1] * o1[1] + o1[2] * o1[2] + o1[3] * o1[3];
                        ss += __shfl_xor(ss, 1); ss += __shfl_xor(ss, 2); ss += __shfl_xor(ss, 4); ss += __shfl_xor(ss, 8);
                        if (sg == 0) OSSQ[grow * 8 + h] = ss; }
                }
                if (s < nsteps) {
#pragma unroll
                    for (int i = 0; i < 4; ++i) { const int idx = tv + 256 * i; *(LAS u32x4*)(VS + (idx >> 4) * 272 + (idx & 15) * 16) = rv[i]; }
#pragma unroll
                    for (int i = 0; i < 4; ++i) { const int idx = tv + 256 * i; rz[i] = *(const u32x4*)(ZB + (row0 + (size_t)s * 64 + (idx >> 4)) * 1024 + hb + (idx & 15) * 8); }
                    if (s + 1 < nsteps) {
#pragma unroll
                        for (int i = 0; i < 4; ++i) { const int idx = tv + 256 * i; rv[i] = *(const u32x4*)(VB + (row0 + (size_t)(s + 1) * 64 + (idx >> 4)) * 1024 + hb + (idx & 15) * 8); }
                    }
                }
            }
            __syncthreads();
            if (s == nsteps) break;
#pragma unroll
            for (int c = 0; c < 4; ++c) {
                bf16x4 qf[8], kf[8];
#pragma unroll
                for (int i = 0; i < 8; ++i) { qf[i] = *(LAS bf16x4*)(QH + (c * 16 + v) * 272 + (16 * i + 4 * kq) * 2); kf[i] = *(LAS bf16x4*)(KH + (c * 16 + v) * 272 + (16 * i + 4 * kq) * 2); }
                bf16x4 vf;
#pragma unroll
                for (int jj = 0; jj < 4; ++jj) vf[jj] = *(LAS short*)(VS + (c * 16 + 4 * kq + jj) * 272 + (16 * wave + v) * 2);
                f32x4 o0 = {0.f, 0.f, 0.f, 0.f}, o1 = o0, a0 = o0, a1 = o0;
#pragma unroll
                for (int i = 0; i < 8; i += 2) { o0 = mfma16(qf[i], pack4(S[i]), o0); o1 = mfma16(qf[i + 1], pack4(S[i + 1]), o1); a0 = mfma16(kf[i], qf[i], a0); a1 = mfma16(kf[i + 1], qf[i + 1], a1); }
                f32x4 at = a0 + a1;
#pragma unroll
                for (int jj = 0; jj < 4; ++jj) if (4 * kq + jj > v) at[jj] = 0.f;
                f32x4 o = mfma16(pack4(at), vf, o0 + o1);
#pragma unroll
                for (int i = 0; i < 8; ++i) { const bf16x4 ktf = *(LAS bf16x4*)(KT + (c * 128 + 16 * i + v) * 40 + 8 * kq); S[i] = mfma16(ktf, vf, S[i]); }
#pragma unroll
                for (int i = 0; i < 8; ++i) { const f32x4 d = *(LAS f32x4*)(DL + c * 128 + 16 * i + 4 * kq); S[i] = S[i] * d; }
#pragma unroll
                for (int jj = 0; jj < 4; ++jj) OB[(c * 16 + 4 * kq + jj) * 132 + 16 * wave + v] = o[jj];
            }
            __syncthreads();
        }
        { float* so = Sout + (4 * kq) * 128 + 16 * wave + v;
#pragma unroll
        for (int i = 0; i < 8; ++i)
#pragma unroll
            for (int jj = 0; jj < 4; ++jj) so[(16 * i + jj) * 128] = S[i][jj]; }
    }
}

__device__ __forceinline__ f32x16 mfma32(bf16x8 a, bf16x8 b, f32x16 c) { return __builtin_amdgcn_mfma_f32_32x32x16_bf16(a, b, c, 0, 0, 0); }
__device__ __forceinline__ v4i16_t ldtr(const LAS unsigned char* q) { return __builtin_amdgcn_ds_read_tr16_b64_v4i16((LAS v4i16_t*)q); }

__device__ __forceinline__ void attn_unit(LAS unsigned char* lds, const bf16_t* QB, const bf16_t* Kb, const bf16_t* Vb, const bf16_t* ZB, bf16_t* AO, const float* subln,
                                          size_t row0q, int h, int ntiles, int qpos0, int nrg, bool partial, float lam, float osc) {
    int tid = threadIdx.x; asm volatile("" : "+v"(tid));
    const int lane = tid & 63, wave = __builtin_amdgcn_readfirstlane(tid >> 6), rg = wave & 3, mp = wave >> 2, ql = lane & 31, hh = lane >> 5;
    const bool active = rg < nrg;
    const float slope2 = ex2(-(float)(h + 1)) * LOG2E;
    bf16x8 qf[4];
    if (active) {
#pragma unroll
        for (int ks = 0; ks < 4; ++ks) qf[ks] = *(const bf16x8*)(QB + (row0q + rg * 32 + ql) * 1024 + mp * 512 + h * 64 + ks * 16 + hh * 8);
    }
    f32x16 ot[4];
#pragma unroll
    for (int dt = 0; dt < 4; ++dt)
#pragma unroll
        for (int r = 0; r < 16; ++r) ot[dt][r] = 0.f;
    float mrow = 0.f, lrow = 0.f;
    const float qpos = (float)(qpos0 + rg * 32 + ql);
    u32x4 sr[4];
    const int kkey = tid >> 3, kseg = tid & 7, vkey = tid >> 4, vseg = tid & 15;
    const int vsw = (vseg ^ (((vkey & 3) << 2) | ((vkey >> 2) & 3))) * 16;
#define ATT_LOAD(jt) do { \
        sr[0] = *(const u32x4*)(Kb + ((size_t)(jt) * 64 + kkey) * 1024 + h * 64 + kseg * 8); sr[1] = *(const u32x4*)(Kb + ((size_t)(jt) * 64 + kkey) * 1024 + 512 + h * 64 + kseg * 8); \
        sr[2] = *(const u32x4*)(Vb + ((size_t)(jt) * 64 + vkey) * 1024 + h * 128 + vseg * 8); sr[3] = *(const u32x4*)(Vb + ((size_t)(jt) * 64 + vkey + 32) * 1024 + h * 128 + vseg * 8); } while (0)
#define ATT_STORE(buf) do { LAS unsigned char* _b = lds + (buf) * 35840; \
        *(LAS u32x4*)(_b + kkey * 144 + kseg * 16) = sr[0]; *(LAS u32x4*)(_b + 9216 + kkey * 144 + kseg * 16) = sr[1]; \
        *(LAS u32x4*)(_b + 18432 + vkey * 256 + vsw) = sr[2]; *(LAS u32x4*)(_b + 18432 + (vkey + 32) * 256 + vsw) = sr[3]; } while (0)
    ATT_LOAD(ntiles - 1); ATT_STORE(0);
    __syncthreads();
    int vo[4][2];
    { const int fh = (lane >> 2) & 3, cl = 2 * ((lane >> 4) & 1) + ((lane >> 1) & 1);
#pragma unroll
      for (int dt = 0; dt < 4; ++dt)
#pragma unroll
          for (int e = 0; e < 2; ++e) vo[dt][e] = 256 * (4 * hh + fh + 8 * e) + 16 * (((dt ^ fh) << 2) + (cl ^ (hh + 2 * e))) + 8 * (lane & 1); }
#define ATT_LDV(dst, sp) do { const LAS unsigned char* _v = lds + 18432 + buf * 35840 + (((sp) >> 1) * 32 + ((sp) & 1) * 16) * 256; _Pragma("unroll") for (int dt = 0; dt < 4; ++dt) { \
        const v4i16_t lo = ldtr(_v + vo[dt][0]), hi = ldtr(_v + vo[dt][1]); \
        dst[dt][0] = lo[0]; dst[dt][1] = lo[1]; dst[dt][2] = lo[2]; dst[dt][3] = lo[3]; dst[dt][4] = hi[0]; dst[dt][5] = hi[1]; dst[dt][6] = hi[2]; dst[dt][7] = hi[3]; } } while (0)
#define ATT_PACK(pf, kt, s8) do { u32x4 pp; pp[0] = pk2(st[kt][s8 + 0], st[kt][s8 + 1]); pp[1] = pk2(st[kt][s8 + 2], st[kt][s8 + 3]); pp[2] = pk2(st[kt][s8 + 4], st[kt][s8 + 5]); pp[3] = pk2(st[kt][s8 + 6], st[kt][s8 + 7]); pf = __builtin_bit_cast(bf16x8, pp); } while (0)
    for (int it = 0; it < ntiles; ++it) {
        const int jt = ntiles - 1 - it;
        const int buf = it & 1;
        if (it + 1 < ntiles) ATT_LOAD(jt - 1);
        const bool doit = active && !(partial && it == 0 && rg < 2);
        if (doit) {
            const LAS unsigned char* Kt = lds + buf * 35840 + mp * 9216;
            bf16x8 kfr[2][4];
#pragma unroll
            for (int kt = 0; kt < 2; ++kt)
#pragma unroll
                for (int ks = 0; ks < 4; ++ks) kfr[kt][ks] = *(LAS bf16x8*)(Kt + (kt * 32 + ql) * 144 + ks * 32 + hh * 16);
            __builtin_amdgcn_sched_barrier(0);
            f32x16 st[2];
            const float dq = qpos - (float)(jt * 64 + 4 * hh);
            { float nsl = -slope2, nm = -mrow; asm volatile("" : "+v"(nsl), "+v"(nm));
#pragma unroll
              for (int kt = 0; kt < 2; ++kt)
#pragma unroll
                for (int r = 0; r < 16; ++r) st[kt][r] = fmaf(nsl, fabsf(dq - (float)(kt * 32 + (r & 3) + 8 * (r >> 2))), nm); }
            __builtin_amdgcn_s_setprio(1);
#pragma unroll
            for (int ks = 0; ks < 4; ++ks) { st[0] = mfma32(kfr[0][ks], qf[ks], st[0]); st[1] = mfma32(kfr[1][ks], qf[ks], st[1]); }
            __builtin_amdgcn_s_setprio(0);
            bf16x8 vf0[4], vf1[4];
            ATT_LDV(vf0, 0); ATT_LDV(vf1, 1);
            __builtin_amdgcn_sched_barrier(0);
            float mx = fmaxf(st[0][0], st[1][0]);
#pragma unroll
            for (int r = 1; r < 16; ++r) mx = fmaxf(mx, fmaxf(st[0][r], st[1][r]));
            mx = fmaxf(mx, __shfl_xor(mx, 32));
            if (__any(mx > 8.f)) {
                const float up = fmaxf(mx, 0.f), alpha = ex2(-up); mrow += up; lrow *= alpha;
#pragma unroll
                for (int dt = 0; dt < 4; ++dt) ot[dt] = ot[dt] * alpha;
#pragma unroll
                for (int kt = 0; kt < 2; ++kt)
#pragma unroll
                    for (int r = 0; r < 16; ++r) st[kt][r] -= up;
            }
            float ps = 0.f;
#pragma unroll
            for (int kt = 0; kt < 2; ++kt)
#pragma unroll
                for (int r = 0; r < 16; ++r) { const float pv = ex2(st[kt][r]); st[kt][r] = pv; ps += pv; }
            lrow += ps;
            bf16x8 pf;
            __builtin_amdgcn_sched_barrier(0);
            ATT_PACK(pf, 0, 0);
            __builtin_amdgcn_s_setprio(1);
#pragma unroll
            for (int dt = 0; dt < 4; ++dt) ot[dt] = mfma32(vf0[dt], pf, ot[dt]);
            __builtin_amdgcn_s_setprio(0);
            ATT_LDV(vf0, 2);
            ATT_PACK(pf, 0, 8);
            __builtin_amdgcn_sched_barrier(0);
            __builtin_amdgcn_s_setprio(1);
#pragma unroll
            for (int dt = 0; dt < 4; ++dt) ot[dt] = mfma32(vf1[dt], pf, ot[dt]);
            __builtin_amdgcn_s_setprio(0);
            ATT_LDV(vf1, 3);
            ATT_PACK(pf, 1, 0);
            __builtin_amdgcn_sched_barrier(0);
            __builtin_amdgcn_s_setprio(1);
#pragma unroll
            for (int dt = 0; dt < 4; ++dt) ot[dt] = mfma32(vf0[dt], pf, ot[dt]);
            ATT_PACK(pf, 1, 8);
#pragma unroll
            for (int dt = 0; dt < 4; ++dt) ot[dt] = mfma32(vf1[dt], pf, ot[dt]);
            __builtin_amdgcn_s_setprio(0);
        }
        if (it + 1 < ntiles) ATT_STORE(buf ^ 1);
        __syncthreads();
    }
#undef ATT_LDV
#undef ATT_PACK
#undef ATT_LOAD
#undef ATT_STORE
    const float lt = lrow + __shfl_xor(lrow, 32);
    const float inv = 1.f / lt;
    LAS float* EX = (LAS float*)(lds + 71680) + (rg * 32 + ql) * 132;
    if (active && mp == 1) {
        const float sc = inv * lam;
#pragma unroll
        for (int dt = 0; dt < 4; ++dt)
#pragma unroll
            for (int g4 = 0; g4 < 4; ++g4) { f32x4 e; e[0] = ot[dt][4 * g4] * sc; e[1] = ot[dt][4 * g4 + 1] * sc; e[2] = ot[dt][4 * g4 + 2] * sc; e[3] = ot[dt][4 * g4 + 3] * sc; *(LAS f32x4*)(EX + dt * 32 + 8 * g4 + 4 * hh) = e; }
    }
    u32x2 zr[4][4];
    if (active && mp == 0) {
        const size_t row = row0q + rg * 32 + ql;
#pragma unroll
        for (int dt = 0; dt < 4; ++dt)
#pragma unroll
            for (int g4 = 0; g4 < 4; ++g4) zr[dt][g4] = *(const u32x2*)(ZB + row * 1024 + h * 128 + dt * 32 + 8 * g4 + 4 * hh);
    }
    __syncthreads();
    if (active && mp == 0) {
        float ss = 0.f;
#pragma unroll
        for (int dt = 0; dt < 4; ++dt)
#pragma unroll
            for (int g4 = 0; g4 < 4; ++g4) { const f32x4 e = *(LAS f32x4*)(EX + dt * 32 + 8 * g4 + 4 * hh);
#pragma unroll
                for (int i = 0; i < 4; ++i) { const float o = ot[dt][4 * g4 + i] * inv - e[i]; ot[dt][4 * g4 + i] = o; ss += o * o; } }
        ss += __shfl_xor(ss, 32);
        const float rs = rsqrtf(ss * (1.f / 128.f) + EPS) * osc;
        const size_t row = row0q + rg * 32 + ql;
#pragma unroll
        for (int dt = 0; dt < 4; ++dt)
#pragma unroll
            for (int g4 = 0; g4 < 4; ++g4) { const int dv = dt * 32 + 8 * g4 + 4 * hh; const f32x4 w = *(const f32x4*)(subln + dv); const u32x2 z = zr[dt][g4];
                u32x2 o; o[0] = pk2(ot[dt][4 * g4] * rs * w[0] * bflo(z[0]), ot[dt][4 * g4 + 1] * rs * w[1] * bfhi(z[0])); o[1] = pk2(ot[dt][4 * g4 + 2] * rs * w[2] * bflo(z[1]), ot[dt][4 * g4 + 3] * rs * w[3] * bfhi(z[1]));
                *(u32x2*)(AO + row * 1024 + h * 128 + dv) = o; }
    }
}

__device__ __forceinline__ void attn_phase(const Params& p, LAS unsigned char* lds, int j, int l) {
    int lane = threadIdx.x & 63; asm volatile("" : "+v"(lane));
    const int G = gridDim.x;
    const float* lv = p.attn_lambda + j * 256;
    const float s01 = wave_sum(lv[lane] * lv[64 + lane]), s23 = wave_sum(lv[128 + lane] * lv[192 + lane]);
    const float lam_init = 0.8f - 0.6f * expf(-0.3f * (float)l);
    const float lam = expf(s01) - expf(s23) + lam_init, osc = 1.f - lam_init;
    const bf16_t* QB = (const bf16_t*)(p.ws + WS_QB); const bf16_t* KB = (const bf16_t*)(p.ws + WS_KB); const bf16_t* VB = (const bf16_t*)(p.ws + WS_VB); const bf16_t* ZB = (const bf16_t*)(p.ws + WS_ZB);
    const bf16_t* KC = (const bf16_t*)(p.ws + WS_KC) + (size_t)j * 16 * KVS * 1024; const bf16_t* VC = (const bf16_t*)(p.ws + WS_VC) + (size_t)j * 16 * KVS * 1024;
    bf16_t* AO = (bf16_t*)(p.ws + WS_AO);
    const float* subln = p.attn_subln + j * 128;
    const bool bal = (G == 256);
    for (int item = blockIdx.x; item < 384; item += G) {
        if (item < 256) { const int b = item >> 3, h = item & 7;
#pragma unroll 1
            for (int qb = 0; qb < 17; ++qb) {
                int bb = b, hq = h, q = qb;
                if (qb == 16) { if (!(bal && item >= 128)) break; bb = (item - 128) >> 3; hq = (item - 128) & 7; q = 7; }
                else if (bal && item < 128 && qb == 7) continue;
                attn_unit(lds, QB, KB + (size_t)bb * 2048 * 1024, VB + (size_t)bb * 2048 * 1024, ZB, AO, subln, (size_t)bb * 2048 + q * 128, hq, 2 * q + 2, q * 128, 4, true, lam, osc);
            }
        } else { const int it = item - 256, b = it >> 3, h = it & 7;
            attn_unit(lds, QB, KC + (size_t)b * KVS * 1024, VC + (size_t)b * KVS * 1024, ZB, AO, subln, (size_t)MP + b * 64, h, 33, 2048, 2, false, lam, osc);
        }
    }
}

__global__ void __launch_bounds__(512, 2) mega_fwd(Params p) {
    extern __shared__ __attribute__((aligned(16))) unsigned char lds_raw[];
    LAS unsigned char* lds = (LAS unsigned char*)lds_raw;
    cg::grid_group grid = cg::this_grid();
    prologue(p, lds);
    grid.sync();
    bf16_t* XA = (bf16_t*)(p.ws + WS_XA); bf16_t* AO = (bf16_t*)(p.ws + WS_AO);
    float* SSQ = (float*)(p.ws + WS_SSQ); float* OSSQ = (float*)(p.ws + WS_OSSQ);
#pragma unroll 1
    for (int l = 0; l < 4; ++l) {
        const int j = l >> 1; const bool attn = (l & 1) != 0;
        {
            pg8::Gemm g{XA, (const bf16_t*)(p.ws + WS_WTIN) + (size_t)l * 4096 * 1024, MT, 4096, 1024};
            pg8::StaticOrder S; S.init(MT, 4096, (int)gridDim.x, (int)blockIdx.x);
            EpiIn E; E.mode = attn ? 1 : 0; E.j = j; E.ws = p.ws; E.outb = p.out; E.qnb = p.attn_q_norm; E.knb = p.attn_k_norm;
            pg8::gemm_phase<EpiIn, pg8::StaticOrder, false>(lds, g, S, E, nullptr);
        }
        grid.sync();
        if (attn) attn_phase(p, lds, j, l); else gla_phase(p, lds, j);
        grid.sync();
        {
            pg8::Gemm g{AO, (const bf16_t*)(p.ws + WS_WTOUT) + (size_t)l * 1024 * 1024, MT, 1024, 1024};
            pg8::StaticOrder S; S.init(MT, 1024, (int)gridDim.x, (int)blockIdx.x);
            EpiOut E; E.out = l == 3 ? p.out : nullptr; E.XA = XA; E.ssq = SSQ; E.ossq = attn ? nullptr : OSSQ;
            pg8::gemm_phase<EpiOut, pg8::StaticOrder, false>(lds, g, S, E, nullptr);
        }
        if (l < 3) grid.sync();
    }
}

extern "C" void kernel_launch(void* const* d_in, const int* in_sizes, int n_in, void* d_out, int out_size, void* d_ws, size_t ws_size, hipStream_t stream) {
    static int grid = 0;
    if (grid == 0) {
        if (n_in != 16 || ws_size < WS_END) { fprintf(stderr, "kernel_launch: unexpected n_in %d / ws_size %zu\n", n_in, ws_size); grid = -1; return; }
        int dev = 0, cus = 0, per_cu = 0;
        hipGetDevice(&dev); hipDeviceGetAttribute(&cus, hipDeviceAttributeMultiprocessorCount, dev);
        if (hipFuncSetAttribute((const void*)mega_fwd, hipFuncAttributeMaxDynamicSharedMemorySize, LDS_BYTES) != hipSuccess) fprintf(stderr, "kernel_launch: hipFuncSetAttribute failed\n");
        if (hipOccupancyMaxActiveBlocksPerMultiprocessor(&per_cu, (const void*)mega_fwd, 512, LDS_BYTES) != hipSuccess || per_cu < 1) { fprintf(stderr, "kernel_launch: occupancy query gave %d\n", per_cu); per_cu = 1; }
        (void)hipGetLastError();
        grid = cus * per_cu;
    }
    if (grid < 0) return;
    Params p{};
    p.x_prompt = (const float*)d_in[0]; p.x_sample = (const float*)d_in[1]; p.cache_k = (const float*)d_in[2]; p.cache_v = (const float*)d_in[3]; p.state_hgrn = (const float*)d_in[4];
    p.norm_w = (const float*)d_in[5]; p.hgrn_w_in = (const float*)d_in[6]; p.hgrn_lb_logits = (const float*)d_in[7]; p.hgrn_onorm_w = (const float*)d_in[8]; p.hgrn_w_out = (const float*)d_in[9];
    p.attn_w_in = (const float*)d_in[10]; p.attn_q_norm = (const float*)d_in[11]; p.attn_k_norm = (const float*)d_in[12]; p.attn_lambda = (const float*)d_in[13]; p.attn_subln = (const float*)d_in[14];
    p.attn_w_out = (const float*)d_in[15];
    p.out = (float*)d_out; p.ws = (unsigned char*)d_ws;
    void* args[] = {&p};
    hipError_t e = hipLaunchCooperativeKernel((const void*)mega_fwd, dim3(grid), dim3(512), args, LDS_BYTES, stream);
    if (e != hipSuccess) fprintf(stderr, "cooperative launch failed: %s (grid %d)\n", hipGetErrorString(e), grid);
}
```

```cpp
#include <hip/hip_runtime.h>
#include <hip/hip_cooperative_groups.h>
#include <cstdio>
#include <cstdint>
namespace cg = cooperative_groups;
namespace pg8 {
#define PG8_LAS __attribute__((address_space(3)))
typedef unsigned short bf16_t;
typedef short bf16x8 __attribute__((ext_vector_type(8)));
typedef float f32x4 __attribute__((ext_vector_type(4)));
typedef unsigned u32x4 __attribute__((ext_vector_type(4)));
constexpr int BM = 256, BK = 64, HALF = 128, HTB = HALF * BK * 2  , STAGE_BYTES = 8 * HTB, NXCD = 8, WGM = 8;

__host__ __device__ __forceinline__ int lds_byte(int r, int c) { const int st = (r >> 4) * 2 + (c >> 5), rr = r & 15, cc = c & 31, ob = rr * 64 + cc * 2; return st * 1024 + (ob ^ (((ob >> 9) & 1) << 5)); }
__host__ __device__ __forceinline__ void stage_rc(int b, int& R, int& C) { const int st = b / 1024, sb = b % 1024, swz = sb ^ (((sb >> 9) & 1) << 5); R = (st >> 1) * 16 + swz / 64; C = (st & 1) * 32 + (swz % 64) / 2; }
__host__ __device__ __forceinline__ int perm32(int rho) { const int n = rho >> 4, i = rho & 15; return 8 * (i >> 2) + 4 * n + (i & 3); }

struct Unit { int pm, pn; };
struct Gemm { const bf16_t* A; const bf16_t* Bt; int M, N, K; };

struct StaticOrder {
    int nM, nN, nwg, G, c;
    __host__ __device__ void init(int M, int N, int G_, int c_) { nM = M / BM; nN = N / BM; nwg = nM * nN; G = G_; c = c_; }
    __host__ __device__ bool next(int i, Unit& u) const {
        const long L = (long)i * G + c; if (L >= nwg) return false;
        int wgid = (int)L; { const int q = nwg / NXCD, r = nwg % NXCD, xcd = wgid % NXCD, off = wgid / NXCD; wgid = (xcd < r ? xcd * (q + 1) : r * (q + 1) + (xcd - r) * q) + off; }
        const int nig = WGM * nN, gid = wgid / nig, fm = gid * WGM, gsz = (nM - fm) < WGM ? (nM - fm) : WGM;
        u.pm = fm + ((wgid % nig) % gsz); u.pn = (wgid % nig) / gsz; return true;
    }
    __device__ __forceinline__ void a_ready(const Unit&) const {}
    __device__ __forceinline__ void done(const Unit&) const {}
};
__device__ __forceinline__ unsigned cvt_pk_bf16(float lo, float hi) { unsigned r; asm volatile("v_cvt_pk_bf16_f32 %0, %1, %2" : "=v"(r) : "v"(lo), "v"(hi)); return r; }
template <class Epi, class Sched, bool STAMP = false>
__device__ __forceinline__ void gemm_phase(PG8_LAS unsigned char* lds, const Gemm g, const Sched& S, const Epi& E, unsigned long long* stamps) {
    int tid_l = threadIdx.x; asm volatile("" : "+v"(tid_l));
    const int tid = tid_l, wid = __builtin_amdgcn_readfirstlane(tid >> 6), lane = tid & 63, wr = wid >> 2, wc = wid & 3, fr = lane & 15, fq = lane >> 4;
    const int K = g.K, nt = K / BK;
    int ts_lo = 0, ts_hi = 0, nts = 0; const unsigned long long rt_entry = STAMP ? (unsigned long long)wall_clock64() : 0ull;
#define PG8_STAMP() do { if (STAMP && wid == 0 && nts < 64) { const unsigned long long _c = (unsigned long long)clock64(); \
        ts_lo = (lane == nts) ? (int)(unsigned)_c : ts_lo; ts_hi = (lane == nts) ? (int)(unsigned)(_c >> 32) : ts_hi; ++nts; } } while (0)
    PG8_STAMP();
    unsigned voffA[2], voffB[2];
#pragma unroll
    for (int i = 0; i < 2; ++i) { int R, C; stage_rc(tid * 16 + i * 8192, R, C); const int Rb = Epi::PERM ? ((R & ~31) + perm32(R & 31)) : R;
        voffA[i] = (unsigned)(R * K + C) * 2u; voffB[i] = (unsigned)(Rb * K + C) * 2u; }
    const size_t kstep = (size_t)(BK * 2);
    const size_t hstep = (size_t)HALF * K * 2;
    const size_t tstep = 2 * hstep;
    const unsigned ldsw = (unsigned)wid * 1024u;
    const int aoff = lds_byte(wr * 64 + fr, fq * 8), boff = lds_byte(wc * 32 + fr, fq * 8);
#define PG8_SA(b, h) (((b) * 2 + (h)) * HTB)
#define PG8_SB(b, h) ((4 + (b) * 2 + (h)) * HTB)
#define PG8_STAGE(bufoff, gbase, voff) do { _Pragma("unroll") for (int _i = 0; _i < 2; ++_i) \
        __builtin_amdgcn_global_load_lds((const unsigned*)((const char*)(gbase) + (voff)[_i]), (PG8_LAS unsigned*)(lds + (bufoff) + ldsw + _i * 8192), 16, 0, 0); } while (0)
#define PG8_LDA(dst, b, h) do { _Pragma("unroll") for (int m = 0; m < 4; ++m) _Pragma("unroll") for (int k = 0; k < 2; ++k) dst[m][k] = *(const PG8_LAS bf16x8*)(lds + PG8_SA(b, h) + aoff + m * 2048 + k * 1024); } while (0)
#define PG8_LDB(dst, b, h) do { _Pragma("unroll") for (int n = 0; n < 2; ++n) _Pragma("unroll") for (int k = 0; k < 2; ++k) dst[n][k] = *(const PG8_LAS bf16x8*)(lds + PG8_SB(b, h) + boff + n * 2048 + k * 1024); } while (0)
#define PG8_MMA(ai, bj, At, Bt) do { __builtin_amdgcn_s_setprio(1); _Pragma("unroll") for (int m = 0; m < 4; ++m) _Pragma("unroll") for (int n = 0; n < 2; ++n) _Pragma("unroll") for (int k = 0; k < 2; ++k) \
        acc[ai][bj][m][n] = __builtin_amdgcn_mfma_f32_16x16x32_bf16(Bt[n][k], At[m][k], acc[ai][bj][m][n], 0, 0, 0); __builtin_amdgcn_s_setprio(0); } while (0)
#define PG8_WAIT_V(n) asm volatile("s_waitcnt vmcnt(" #n ")" ::: "memory")
#define PG8_WAIT_L(n) asm volatile("s_waitcnt lgkmcnt(" #n ")" ::: "memory")
#define PG8_BAR __builtin_amdgcn_s_barrier()
#define PG8_SCHED __builtin_amdgcn_sched_barrier(0)
    Unit cur, nxt; int ui = 0;
    if (!S.next(0, cur)) return;
    f32x4 acc[2][2][4][2];
#pragma unroll
    for (int a = 0; a < 2; ++a)
#pragma unroll
        for (int b = 0; b < 2; ++b)
#pragma unroll
            for (int m = 0; m < 4; ++m)
#pragma unroll
                for (int n = 0; n < 2; ++n) acc[a][b][m][n] = (f32x4){0.f, 0.f, 0.f, 0.f};
    bf16x8 At[4][2], B0[2][2], B1[2][2];
    const char* cA = (const char*)g.A + (size_t)cur.pm * tstep; const char* cB = (const char*)g.Bt + (size_t)cur.pn * tstep;
    S.a_ready(cur);
    PG8_STAGE(PG8_SB(0, 0), cB, voffB); PG8_STAGE(PG8_SA(0, 0), cA, voffA); PG8_STAGE(PG8_SB(0, 1), cB + hstep, voffB); PG8_STAGE(PG8_SA(0, 1), cA + hstep, voffA);
    if (wr == 1) PG8_BAR;
    PG8_WAIT_V(4); PG8_BAR;
    PG8_STAGE(PG8_SB(1, 0), cB + kstep, voffB); PG8_STAGE(PG8_SA(1, 0), cA + kstep, voffA); PG8_STAGE(PG8_SB(1, 1), cB + hstep + kstep, voffB);
    PG8_WAIT_V(6); PG8_BAR;
    PG8_STAMP();
    for (;;) {
        const bool has_next = S.next(ui + 1, nxt);
        const char* nA = has_next ? (const char*)g.A + (size_t)nxt.pm * tstep : cA; const char* nB = has_next ? (const char*)g.Bt + (size_t)nxt.pn * tstep : cB;
        for (int t = 0; t < nt; t += 2) {
            const bool last = (t == nt - 2);
            const char* a1 = cA + (size_t)(t + 1) * kstep;
            const char* a2 = last ? nA : cA + (size_t)(t + 2) * kstep; const char* b2 = last ? nB : cB + (size_t)(t + 2) * kstep;
            const char* a3 = a2 + kstep; const char* b3 = b2 + kstep;
            if (last && has_next) S.a_ready(nxt);
            PG8_LDB(B0, 0, 0); PG8_SCHED; PG8_LDA(At, 0, 0); PG8_STAGE(PG8_SA(1, 1), a1 + hstep, voffA);
            PG8_WAIT_L(8); PG8_BAR; PG8_WAIT_L(0); PG8_MMA(0, 0, At, B0); PG8_BAR; PG8_SCHED;
            PG8_LDB(B1, 0, 1); PG8_STAGE(PG8_SB(0, 0), b2, voffB);
            PG8_BAR; PG8_WAIT_L(0); PG8_MMA(0, 1, At, B1); PG8_BAR;
            PG8_LDA(At, 0, 1); PG8_STAGE(PG8_SA(0, 0), a2, voffA);
            PG8_BAR; PG8_WAIT_L(0); PG8_MMA(1, 0, At, B0); PG8_BAR; PG8_SCHED;
            PG8_STAGE(PG8_SB(0, 1), b2 + hstep, voffB);
            PG8_WAIT_V(6); PG8_BAR; PG8_MMA(1, 1, At, B1); PG8_BAR;
            PG8_LDB(B0, 1, 0); PG8_SCHED; PG8_LDA(At, 1, 0); PG8_STAGE(PG8_SA(0, 1), a2 + hstep, voffA);
            PG8_WAIT_L(8); PG8_BAR; PG8_WAIT_L(0); PG8_MMA(0, 0, At, B0); PG8_BAR; PG8_SCHED;
            PG8_LDB(B1, 1, 1); PG8_STAGE(PG8_SB(1, 0), b3, voffB);
            PG8_BAR; PG8_WAIT_L(0); PG8_MMA(0, 1, At, B1); PG8_BAR;
            PG8_LDA(At, 1, 1); PG8_STAGE(PG8_SA(1, 0), a3, voffA);
            PG8_BAR; PG8_WAIT_L(0); PG8_MMA(1, 0, At, B0); PG8_BAR; PG8_SCHED;
            PG8_STAGE(PG8_SB(1, 1), b3 + hstep, voffB);
            PG8_WAIT_V(6); PG8_BAR; PG8_MMA(1, 1, At, B1); PG8_BAR;
        }
        PG8_STAMP();
        if constexpr (!Epi::AFTER_DRAIN) { E(acc, cur, wr, wc, fr, fq); S.done(cur); }
        PG8_STAMP();
        if (!has_next) break;
#pragma unroll
        for (int a = 0; a < 2; ++a)
#pragma unroll
            for (int b = 0; b < 2; ++b)
#pragma unroll
                for (int m = 0; m < 4; ++m)
#pragma unroll
                    for (int n = 0; n < 2; ++n) acc[a][b][m][n] = (f32x4){0.f, 0.f, 0.f, 0.f};
        cur = nxt; cA = nA; cB = nB; ++ui;
    }
    PG8_WAIT_V(0);
    if (wr == 0) PG8_BAR;
    PG8_BAR;
    if constexpr (Epi::AFTER_DRAIN) { E.fused(acc, cur, wr, wc, fr, fq, lds, wid, lane); S.done(cur); }
    PG8_STAMP();
    if (STAMP && wid == 0) { stamps[lane] = lane < nts ? (((unsigned long long)(unsigned)ts_hi << 32) | (unsigned)ts_lo) : 0ull;
        if (lane == 62) stamps[62] = rt_entry; if (lane == 63) stamps[63] = (unsigned long long)wall_clock64(); }
#undef PG8_STAMP
#undef PG8_SA
#undef PG8_SB
#undef PG8_STAGE
#undef PG8_LDA
#undef PG8_LDB
#undef PG8_MMA
#undef PG8_WAIT_V
#undef PG8_WAIT_L
#undef PG8_BAR
#undef PG8_SCHED
}
}

#define LAS __attribute__((address_space(3)))
using pg8::bf16_t; using pg8::bf16x8; using pg8::f32x4; using pg8::u32x4;
typedef short bf16x4 __attribute__((ext_vector_type(4)));
typedef float f32x16 __attribute__((ext_vector_type(16)));
typedef unsigned u32x2 __attribute__((ext_vector_type(2)));
typedef short v4i16_t __attribute__((ext_vector_type(4)));

constexpr int DM = 1024, MP = 65536, MS = 1024, MT = MP + MS, KVS = 2112;
constexpr float EPS = 1e-6f, LOG2E = 1.4426950408889634f;
constexpr size_t O_YP = 0, O_YS = 67108864, O_KP = 68157440, O_VP = 202375168, O_KS = 336592896, O_VS = 338690048, O_SP = 340787200, O_SS = 349175808;
constexpr size_t MiB = 1u << 20;
constexpr size_t WS_WTIN = 0, WS_WTOUT = 32 * MiB, WS_LB = 40 * MiB, WS_SSQ = 41 * MiB, WS_OSSQ = 46 * MiB, WS_XA = 64 * MiB, WS_QB = 200 * MiB, WS_KB = 336 * MiB,
                 WS_VB = 472 * MiB, WS_ZB = 608 * MiB, WS_AO = 744 * MiB, WS_KC = 880 * MiB, WS_VC = 1016 * MiB, WS_END = 1152 * MiB;
constexpr int LDS_BYTES = 147456;

struct Params {
    const float *x_prompt, *x_sample, *cache_k, *cache_v, *state_hgrn, *norm_w, *hgrn_w_in, *hgrn_lb_logits, *hgrn_onorm_w, *hgrn_w_out,
                *attn_w_in, *attn_q_norm, *attn_k_norm, *attn_lambda, *attn_subln, *attn_w_out;
    float* out; unsigned char* ws;
};

__device__ __forceinline__ unsigned pk2(float lo, float hi) { typedef float f2 __attribute__((ext_vector_type(2))); typedef __bf16 b2 __attribute__((ext_vector_type(2)));
    f2 v = {lo, hi}; b2 b = __builtin_convertvector(v, b2); return __builtin_bit_cast(unsigned, b); }
__device__ __forceinline__ float bflo(unsigned u) { return __uint_as_float(u << 16); }
__device__ __forceinline__ float bfhi(unsigned u) { return __uint_as_float(u & 0xffff0000u); }
__device__ __forceinline__ float wave_sum(float v) {
#pragma unroll
    for (int o = 32; o > 0; o >>= 1) v += __shfl_xor(v, o);
    return v; }
__device__ __forceinline__ float ex2(float x) { return __builtin_amdgcn_exp2f(x); }
__device__ __forceinline__ u32x4 pack8(f32x4 a, f32x4 b) { u32x4 r; r[0] = pk2(a[0], a[1]); r[1] = pk2(a[2], a[3]); r[2] = pk2(b[0], b[1]); r[3] = pk2(b[2], b[3]); return r; }

struct EpiIn {
    static constexpr bool PERM = true, AFTER_DRAIN = false;
    int mode, j;
    unsigned char* ws; float* outb; const float* qnb; const float* knb;
    __device__ __forceinline__ void operator()(const f32x4 (&acc)[2][2][4][2], const pg8::Unit& u, int wr, int wc, int fr, int fq) const {
        const float* ssq = (const float*)(ws + WS_SSQ); const float* lb = (const float*)(ws + WS_LB) + j * 1024; const float* qn = qnb + j * 64; const float* kn = knb + j * 64;
        bf16_t* QB = (bf16_t*)(ws + WS_QB); bf16_t* KB = (bf16_t*)(ws + WS_KB); bf16_t* VB = (bf16_t*)(ws + WS_VB); bf16_t* ZB = (bf16_t*)(ws + WS_ZB);
        bf16_t* KC = (bf16_t*)(ws + WS_KC) + (size_t)j * 16 * KVS * 1024; bf16_t* VC = (bf16_t*)(ws + WS_VC) + (size_t)j * 16 * KVS * 1024;
        float* okp = outb + O_KP + (size_t)j * MP * 1024; float* ovp = outb + O_VP + (size_t)j * MP * 1024; float* oks = outb + O_KS + (size_t)j * MS * 1024; float* ovs = outb + O_VS + (size_t)j * MS * 1024;
        const int region = u.pn >> 2, pg = u.pn & 3;
        const int cb = pg * 256 + wc * 64 + 8 * fq;
        const bool samp = u.pm >= 256;
        float rsv[2][4];
#pragma unroll
        for (int ai = 0; ai < 2; ++ai)
#pragma unroll
            for (int m = 0; m < 4; ++m) { const int row = u.pm * 256 + ai * 128 + wr * 64 + m * 16 + fr;
                const f32x4 s4 = *(const f32x4*)(ssq + (size_t)row * 16 + 4 * fq); rsv[ai][m] = (s4[0] + s4[1]) + (s4[2] + s4[3]); }
#pragma unroll
        for (int ai = 0; ai < 2; ++ai)
#pragma unroll
            for (int m = 0; m < 4; ++m) { float t = rsv[ai][m]; t += __shfl_xor(t, 16); t += __shfl_xor(t, 32); rsv[ai][m] = rsqrtf(t * (1.f / 1024.f) + EPS); }
        f32x4 wq[2][2];
        { const float* wb = mode == 0 ? lb + cb : (region == 0 ? qn : kn) + 8 * fq;
#pragma unroll
          for (int bj = 0; bj < 2; ++bj)
#pragma unroll
              for (int n = 0; n < 2; ++n) wq[bj][n] = *(const f32x4*)(wb + 32 * bj + 4 * n); }
#pragma unroll
        for (int ai = 0; ai < 2; ++ai)
#pragma unroll
            for (int m = 0; m < 4; ++m) {
                const int row = u.pm * 256 + ai * 128 + wr * 64 + m * 16 + fr;
                const float rs = rsv[ai][m];
                f32x4 v[2][2];
#pragma unroll
                for (int bj = 0; bj < 2; ++bj)
#pragma unroll
                    for (int n = 0; n < 2; ++n) v[bj][n] = acc[ai][bj][m][n] * rs;
                if (region == 3) {
#pragma unroll
                    for (int bj = 0; bj < 2; ++bj) {
#pragma unroll
                        for (int n = 0; n < 2; ++n)
#pragma unroll
                            for (int j = 0; j < 4; ++j) { const float x = v[bj][n][j]; v[bj][n][j] = x * __builtin_amdgcn_rcpf(1.f + ex2(-LOG2E * x)); }
                        *(u32x4*)(ZB + (size_t)row * 1024 + cb + 32 * bj) = pack8(v[bj][0], v[bj][1]);
                    }
                } else if (mode == 0) {
                    if (region == 0) {
#pragma unroll
                        for (int bj = 0; bj < 2; ++bj) *(u32x4*)(QB + (size_t)row * 1024 + cb + 32 * bj) = pack8(v[bj][0] * 0.08838834764831845f, v[bj][1] * 0.08838834764831845f);
                    } else if (region == 1) {
#pragma unroll
                        for (int bj = 0; bj < 2; ++bj) {
#pragma unroll
                            for (int n = 0; n < 2; ++n) { const f32x4 l4 = wq[bj][n];
#pragma unroll
                                for (int j = 0; j < 4; ++j) { const float sg = __builtin_amdgcn_rcpf(1.f + ex2(-LOG2E * v[bj][n][j])); const float f = l4[j] + (1.f - l4[j]) * sg; v[bj][n][j] = __builtin_amdgcn_logf(f); } }
                            *(u32x4*)(KB + (size_t)row * 1024 + cb + 32 * bj) = pack8(v[bj][0], v[bj][1]);
                        }
                    } else {
#pragma unroll
                        for (int bj = 0; bj < 2; ++bj) *(u32x4*)(VB + (size_t)row * 1024 + cb + 32 * bj) = pack8(v[bj][0], v[bj][1]);
                    }
                } else {
                    const int srow = row - MP;
                    const size_t crow = samp ? (size_t)(srow >> 6) * KVS + 2048 + (srow & 63) : 0;
                    if (region <= 1) {
                        float ss = 0.f;
#pragma unroll
                        for (int bj = 0; bj < 2; ++bj)
#pragma unroll
                            for (int n = 0; n < 2; ++n)
#pragma unroll
                                for (int j = 0; j < 4; ++j) ss += v[bj][n][j] * v[bj][n][j];
                        ss += __shfl_xor(ss, 16); ss += __shfl_xor(ss, 32);
                        float r2 = rsqrtf(ss * (1.f / 64.f) + EPS);
                        if (region == 0) r2 *= 0.125f * LOG2E;
#pragma unroll
                        for (int bj = 0; bj < 2; ++bj)
#pragma unroll
                            for (int n = 0; n < 2; ++n) v[bj][n] = v[bj][n] * wq[bj][n] * r2;
                        if (region == 0) {
#pragma unroll
                            for (int bj = 0; bj < 2; ++bj) *(u32x4*)(QB + (size_t)row * 1024 + cb + 32 * bj) = pack8(v[bj][0], v[bj][1]);
                        } else {
                            float* of = samp ? oks + (size_t)srow * 1024 : okp + (size_t)row * 1024;
                            bf16_t* ob = samp ? KC + crow * 1024 : KB + (size_t)row * 1024;
#pragma unroll
                            for (int bj = 0; bj < 2; ++bj) { __builtin_nontemporal_store(v[bj][0], (f32x4*)(of + cb + 32 * bj)); __builtin_nontemporal_store(v[bj][1], (f32x4*)(of + cb + 32 * bj + 4)); *(u32x4*)(ob + cb + 32 * bj) = pack8(v[bj][0], v[bj][1]); }
                        }
                    } else {
                        float* of = samp ? ovs + (size_t)srow * 1024 : ovp + (size_t)row * 1024;
                        bf16_t* ob = samp ? VC + crow * 1024 : VB + (size_t)row * 1024;
#pragma unroll
                        for (int bj = 0; bj < 2; ++bj) { __builtin_nontemporal_store(v[bj][0], (f32x4*)(of + cb + 32 * bj)); __builtin_nontemporal_store(v[bj][1], (f32x4*)(of + cb + 32 * bj + 4)); *(u32x4*)(ob + cb + 32 * bj) = pack8(v[bj][0], v[bj][1]); }
                    }
                }
            }
    }
};

struct EpiOut {
    static constexpr bool PERM = true, AFTER_DRAIN = false;
    float* out;
    bf16_t* XA;
    float* ssq;
    const float* ossq;
    __device__ __forceinline__ void operator()(const f32x4 (&acc)[2][2][4][2], const pg8::Unit& u, int wr, int wc, int fr, int fq) const {
        const int cb = u.pn * 256 + wc * 32 + 8 * fq;
        float rsv[8];
        if (ossq) {
#pragma unroll
            for (int r = 0; r < 8; ++r) { const int row = u.pm * 256 + (r >> 2) * 128 + wr * 64 + (r & 3) * 16 + fr;
                const f32x4 s4 = *(const f32x4*)(ossq + (size_t)row * 8 + 4 * (fq & 1)); rsv[r] = (s4[0] + s4[1]) + (s4[2] + s4[3]); }
#pragma unroll
            for (int r = 0; r < 8; ++r) { float t = rsv[r]; t += __shfl_xor(t, 16); rsv[r] = rsqrtf(t * (1.f / 1024.f) + EPS); }
        } else {
#pragma unroll
            for (int r = 0; r < 8; ++r) rsv[r] = 1.f;
        }
        u32x4 xq[4][2];
#pragma unroll
        for (int r = 0; r < 3; ++r) { const int row = u.pm * 256 + (r >> 2) * 128 + wr * 64 + (r & 3) * 16 + fr;
#pragma unroll
            for (int bj = 0; bj < 2; ++bj) xq[r][bj] = *(const u32x4*)(XA + (size_t)row * 1024 + cb + 128 * bj); }
#pragma unroll
        for (int r = 0; r < 8; ++r) {
            const int ai = r >> 2, m = r & 3;
            const int row = u.pm * 256 + ai * 128 + wr * 64 + m * 16 + fr;
            if (r + 3 < 8) { const int rn = r + 3, rown = u.pm * 256 + (rn >> 2) * 128 + wr * 64 + (rn & 3) * 16 + fr;
#pragma unroll
                for (int bj = 0; bj < 2; ++bj) xq[rn & 3][bj] = *(const u32x4*)(XA + (size_t)rown * 1024 + cb + 128 * bj); }
            const u32x4* xc = xq[r & 3];
            const float rs = rsv[r];
            float part = 0.f;
#pragma unroll
            for (int bj = 0; bj < 2; ++bj) {
                const int c = cb + 128 * bj;
                f32x4 x0, x1; x0[0] = bflo(xc[bj][0]); x0[1] = bfhi(xc[bj][0]); x0[2] = bflo(xc[bj][1]); x0[3] = bfhi(xc[bj][1]); x1[0] = bflo(xc[bj][2]); x1[1] = bfhi(xc[bj][2]); x1[2] = bflo(xc[bj][3]); x1[3] = bfhi(xc[bj][3]);
                const f32x4 y0 = x0 + acc[ai][bj][m][0] * rs, y1 = x1 + acc[ai][bj][m][1] * rs;
                if (out) { __builtin_nontemporal_store(y0, (f32x4*)(out + (size_t)row * 1024 + c)); __builtin_nontemporal_store(y1, (f32x4*)(out + (size_t)row * 1024 + c + 4)); }
                *(u32x4*)(XA + (size_t)row * 1024 + c) = pack8(y0, y1);
#pragma unroll
                for (int j = 0; j < 4; ++j) part += y0[j] * y0[j] + y1[j] * y1[j];
            }
            part += __shfl_xor(part, 16); part += __shfl_xor(part, 32);
            if (fq == 0) ssq[(size_t)row * 16 + u.pn * 4 + wc] = part;
        }
    }
};

__device__ __forceinline__ void phase_skew(int k) {
    const unsigned long long t0 = __builtin_amdgcn_s_memrealtime(); while (__builtin_amdgcn_s_memrealtime() - t0 < (unsigned long long)(k * 600)) __builtin_amdgcn_s_sleep(32);
}

__device__ __forceinline__ void prologue(const Params& p, LAS unsigned char* lds) {
    int tid = threadIdx.x; asm volatile("" : "+v"(tid));
    const int G = gridDim.x, bx = blockIdx.x, wave = tid >> 6, lane = tid & 63;
    LAS float* ts = (LAS float*)lds;
    bf16_t* wtin = (bf16_t*)(p.ws + WS_WTIN); bf16_t* wtout = (bf16_t*)(p.ws + WS_WTOUT);
    for (int tile = bx; tile < 5120; tile += G) {
        const float* W; bf16_t* WT; int N, ntile, ktile; const float* nw = nullptr; bool perm;
        if (tile < 4096) { const int l = tile >> 10, t = tile & 1023; ntile = t >> 3; ktile = t & 7; N = 4096; perm = true;
            W = ((l & 1) ? p.attn_w_in : p.hgrn_w_in) + (size_t)(l >> 1) * 1024 * 4096; WT = wtin + (size_t)l * 4096 * 1024; nw = p.norm_w + l * 1024; }
        else { const int t2 = tile - 4096, l = t2 >> 8, t = t2 & 255; ntile = t >> 3; ktile = t & 7; N = 1024; perm = false;
            W = ((l & 1) ? p.attn_w_out : p.hgrn_w_out) + (size_t)(l >> 1) * 1024 * 1024; WT = wtout + (size_t)l * 1024 * 1024; }
        const int vcol0 = ntile * 32, k0 = ktile * 128;
        int real0 = vcol0;
        if (perm) { const int region = vcol0 >> 10, rv = vcol0 & 1023, pg = rv >> 8, rem = rv & 255, bj = rem >> 7, wc = (rem & 127) >> 5; real0 = region * 1024 + pg * 256 + wc * 64 + bj * 32; }
#pragma unroll
        for (int i = 0; i < 2; ++i) { const int k = (tid >> 3) + 64 * i, c4 = (tid & 7) * 4;
            const f32x4 v = *(const f32x4*)(W + (size_t)(k0 + k) * N + real0 + c4); const float s = nw ? nw[k0 + k] : 1.f;
#pragma unroll
            for (int e = 0; e < 4; ++e) ts[k * 33 + c4 + e] = v[e] * s; }
        __syncthreads();
        { const int n = tid >> 4, ks = (tid & 15) * 8; f32x4 a, b;
#pragma unroll
            for (int e = 0; e < 4; ++e) { a[e] = ts[(ks + e) * 33 + n]; b[e] = ts[(ks + 4 + e) * 33 + n]; }
            *(u32x4*)(WT + (size_t)(vcol0 + n) * 1024 + k0 + ks) = pack8(a, b); }
        __syncthreads();
    }
    bf16_t* XA = (bf16_t*)(p.ws + WS_XA); float* SSQ = (float*)(p.ws + WS_SSQ);
    for (int row = bx * 8 + wave; row < MT; row += G * 8) {
        const float* xr = row < MP ? p.x_prompt + (size_t)row * 1024 : p.x_sample + (size_t)(row - MP) * 1024;
        float ss = 0.f;
#pragma unroll
        for (int i = 0; i < 4; ++i) { const f32x4 v = *(const f32x4*)(xr + (lane + 64 * i) * 4); ss += v[0] * v[0] + v[1] * v[1] + v[2] * v[2] + v[3] * v[3];
            u32x2 o; o[0] = pk2(v[0], v[1]); o[1] = pk2(v[2], v[3]); *(u32x2*)(XA + (size_t)row * 1024 + (lane + 64 * i) * 4) = o; }
        ss = wave_sum(ss);
        if (lane < 16) SSQ[(size_t)row * 16 + lane] = lane == 0 ? ss : 0.f;
    }
    { bf16_t* KC = (bf16_t*)(p.ws + WS_KC); bf16_t* VC = (bf16_t*)(p.ws + WS_VC);
      const size_t n8 = (size_t)2 * 16 * 2048 * 1024 / 8;
      for (size_t i0 = (size_t)bx * 2048 + tid; i0 < 2 * n8; i0 += (size_t)G * 2048) {
          f32x4 va[4], vb[4]; bf16_t* dst[4];
#pragma unroll
          for (int q = 0; q < 4; ++q) { const size_t i = i0 + 512 * q; const bool wh = i >= n8; const size_t e = (wh ? i - n8 : i) * 8; const size_t jb = e >> 21, rem = e & ((1u << 21) - 1);
              const float* src = (wh ? p.cache_v : p.cache_k) + e; dst[q] = (wh ? VC : KC) + jb * ((size_t)KVS * 1024) + rem;
              va[q] = __builtin_nontemporal_load((const f32x4*)src); vb[q] = __builtin_nontemporal_load((const f32x4*)src + 1); }
#pragma unroll
          for (int q = 0; q < 4; ++q) *(u32x4*)dst[q] = pack8(va[q], vb[q]);
      } }
    if (bx == 0) { float* LB = (float*)(p.ws + WS_LB);
        for (int c = tid; c < 1024; c += 512) { const float l0 = p.hgrn_lb_logits[c], l1 = p.hgrn_lb_logits[1024 + c]; LB[c] = 0.f; LB[1024 + c] = 1.f / (1.f + expf(l0 - l1)); } }
}

__device__ __forceinline__ f32x4 mfma16(bf16x4 a, bf16x4 b, f32x4 c) { return __builtin_amdgcn_mfma_f32_16x16x16bf16_1k(a, b, c, 0, 0, 0); }
__device__ __forceinline__ bf16x4 pack4(f32x4 a) { u32x2 r; r[0] = pk2(a[0], a[1]); r[1] = pk2(a[2], a[3]); return __builtin_bit_cast(bf16x4, r); }

__device__ __forceinline__ void gla_phase(const Params& p, LAS unsigned char* lds, int j) {
    int tid = threadIdx.x; asm volatile("" : "+v"(tid));
    const int lane = tid & 63, wave = __builtin_amdgcn_readfirstlane(tid >> 6), G = gridDim.x;
    LAS unsigned char* QH = lds; LAS unsigned char* KH = lds + 17408; LAS unsigned char* KT = lds + 34816; LAS unsigned char* VS = lds + 55296;
    LAS float* OB = (LAS float*)(lds + 72704); LAS float* DL = (LAS float*)(lds + 106496);
    const bf16_t* QB = (const bf16_t*)(p.ws + WS_QB); const bf16_t* GB = (const bf16_t*)(p.ws + WS_KB); const bf16_t* VB = (const bf16_t*)(p.ws + WS_VB); const bf16_t* ZB = (const bf16_t*)(p.ws + WS_ZB);
    bf16_t* AO = (bf16_t*)(p.ws + WS_AO); float* OSSQ = (float*)(p.ws + WS_OSSQ);
    for (int item = blockIdx.x; item < 384; item += G) {
        int lane_l = lane; asm volatile("" : "+v"(lane_l));
        const int v = lane_l & 15, kq = lane_l >> 4;
        const int tv = (wave - 4) * 64 + lane_l;
        int b, h, T; size_t row0; const float* S0; float* Sout;
        if (item < 256) { b = item >> 3; h = item & 7; T = 2048; row0 = (size_t)b * 2048; S0 = nullptr; Sout = p.out + O_SP + ((size_t)(j * 32 + b) * 8 + h) * 16384; }
        else { const int it = item - 256; b = it >> 3; h = it & 7; T = 64; row0 = (size_t)MP + b * 64; S0 = p.state_hgrn + ((size_t)(j * 16 + b) * 8 + h) * 16384; Sout = p.out + O_SS + ((size_t)(j * 16 + b) * 8 + h) * 16384; }
        f32x4 S[8];
#pragma unroll
        for (int i = 0; i < 8; ++i) S[i] = (f32x4){0.f, 0.f, 0.f, 0.f};
        if (S0) {
            const float* sp = S0 + (4 * kq) * 128 + 16 * wave + v;
#pragma unroll
            for (int i = 0; i < 8; ++i)
#pragma unroll
                for (int jj = 0; jj < 4; ++jj) S[i][jj] = sp[(16 * i + jj) * 128];
        }
        const int nsteps = T >> 6;
        unsigned rq[16], rg[16]; u32x4 rv[4], rz[4]; f32x4 ow0, ow1;
        const size_t hb = (size_t)h * 128;
        if (wave < 4) {
#pragma unroll
            for (int t = 0; t < 16; ++t) { const size_t r = row0 + wave * 16 + t; rq[t] = *(const unsigned*)(QB + r * 1024 + hb + 2 * lane); rg[t] = *(const unsigned*)(GB + r * 1024 + hb + 2 * lane); }
        } else {
#pragma unroll
            for (int i = 0; i < 4; ++i) { const int idx = tv + 256 * i; rv[i] = *(const u32x4*)(VB + (row0 + (idx >> 4)) * 1024 + hb + (idx & 15) * 8); }
            ow0 = *(const f32x4*)(p.hgrn_onorm_w + j * 1024 + hb + (tv & 15) * 8); ow1 = *(const f32x4*)(p.hgrn_onorm_w + j * 1024 + hb + (tv & 15) * 8 + 4);
        }
        for (int s = 0; s <= nsteps; ++s) {
            if (wave < 4) {
                if (s < nsteps) {
                    float e0 = 1.f, e1 = 1.f;
#pragma unroll
                    for (int t = 0; t < 16; ++t) {
                        const unsigned q2 = rq[t], g2 = rg[t];
                        const float fa = ex2(bflo(g2)), fb = ex2(bfhi(g2));
                        e0 *= fa; e1 *= fb;
                        const float qa = bflo(q2) * e0, qb = bfhi(q2) * e1;
                        const float ka = (1.f - fa) * __builtin_amdgcn_rcpf(fmaxf(e0, 7.5e-37f)), kb = (1.f - fb) * __builtin_amdgcn_rcpf(fmaxf(e1, 7.5e-37f));
                        const int row = wave * 16 + t;
                        *(LAS unsigned*)(QH + row * 272 + lane * 4) = pk2(qa, qb);
                        const unsigned kk = pk2(ka, kb);
                        *(LAS unsigned*)(KH + row * 272 + lane * 4) = kk;
                        *(LAS unsigned short*)(KT + (wave * 128 + 2 * lane) * 40 + t * 2) = (unsigned short)(kk & 0xffffu);
                        *(LAS unsigned short*)(KT + (wave * 128 + 2 * lane + 1) * 40 + t * 2) = (unsigned short)(kk >> 16);
                    }
                    DL[wave * 128 + 2 * lane] = e0; DL[wave * 128 + 2 * lane + 1] = e1;
                    if (s + 1 < nsteps) {
#pragma unroll
                        for (int t = 0; t < 16; ++t) { const size_t r = row0 + (s + 1) * 64 + wave * 16 + t; rq[t] = *(const unsigned*)(QB + r * 1024 + hb + 2 * lane); rg[t] = *(const unsigned*)(GB + r * 1024 + hb + 2 * lane); }
                    }
                }
            } else {
                if (s > 0) {
#pragma unroll
                    for (int i = 0; i < 4; ++i) { const int idx = tv + 256 * i, r = idx >> 4, sg = idx & 15;
                        const f32x4 o0 = *(LAS f32x4*)(OB + r * 132 + sg * 8), o1 = *(LAS f32x4*)(OB + r * 132 + sg * 8 + 4);
                        const u32x4 z = rz[i];
                        f32x4 a0, a1;
                        a0[0] = o0[0] * ow0[0] * bflo(z[0]); a0[1] = o0[1] * ow0[1] * bfhi(z[0]); a0[2] = o0[2] * ow0[2] * bflo(z[1]); a0[3] = o0[3] * ow0[3] * bfhi(z[1]);
                        a1[0] = o1[0] * ow1[0] * bflo(z[2]); a1[1] = o1[1] * ow1[1] * bfhi(z[2]); a1[2] = o1[2] * ow1[2] * bflo(z[3]); a1[3] = o1[3] * ow1[3] * bfhi(z[3]);
                        const size_t grow = row0 + (size_t)(s - 1) * 64 + r;
                        *(u32x4*)(AO + grow * 1024 + hb + sg * 8) = pack8(a0, a1);
                        float ss = o0[0] * o0[0] + o0[1] * o0[1] + o0[2] * o0[2] + o0[3] * o0[3] + o1[0] * o1[0] + o1[1] * o1[1] + o1[2] * o1[2] + o1[3] * o1[3];
                        ss += __shfl_xor(ss, 1); ss += __shfl_xor(ss, 2); ss += __shfl_xor(ss, 4); ss += __shfl_xor(ss, 8);
                        if (sg == 0) OSSQ[grow * 8 + h] = ss; }
                }
                if (s < nsteps) {
#pragma unroll
                    for (int i = 0; i < 4; ++i) { const int idx = tv + 256 * i; *(LAS u32x4*)(VS + (idx >> 4) * 272 + (idx & 15) * 16) = rv[i]; }
#pragma unroll
                    for (int i = 0; i < 4; ++i) { const int idx = tv + 256 * i; rz[i] = *(const u32x4*)(ZB + (row0 + (size_t)s * 64 + (idx >> 4)) * 1024 + hb + (idx & 15) * 8); }
                    if (s + 1 < nsteps) {
#pragma unroll
                        for (int i = 0; i < 4; ++i) { const int idx = tv + 256 * i; rv[i] = *(const u32x4*)(VB + (row0 + (size_t)(s + 1) * 64 + (idx >> 4)) * 1024 + hb + (idx & 15) * 8); }
                    }
                }
            }
            __syncthreads();
            if (s == nsteps) break;
#pragma unroll
            for (int c = 0; c < 4; ++c) {
                bf16x4 qf[8], kf[8];
#pragma unroll
                for (int i = 0; i < 8; ++i) { qf[i] = *(LAS bf16x4*)(QH + (c * 16 + v) * 272 + (16 * i + 4 * kq) * 2); kf[i] = *(LAS bf16x4*)(KH + (c * 16 + v) * 272 + (16 * i + 4 * kq) * 2); }
                bf16x4 vf;
#pragma unroll
                for (int jj = 0; jj < 4; ++jj) vf[jj] = *(LAS short*)(VS + (c * 16 + 4 * kq + jj) * 272 + (16 * wave + v) * 2);
                f32x4 o0 = {0.f, 0.f, 0.f, 0.f}, o1 = o0, a0 = o0, a1 = o0;
#pragma unroll
                for (int i = 0; i < 8; i += 2) { o0 = mfma16(qf[i], pack4(S[i]), o0); o1 = mfma16(qf[i + 1], pack4(S[i + 1]), o1); a0 = mfma16(kf[i], qf[i], a0); a1 = mfma16(kf[i + 1], qf[i + 1], a1); }
                f32x4 at = a0 + a1;
#pragma unroll
                for (int jj = 0; jj < 4; ++jj) if (4 * kq + jj > v) at[jj] = 0.f;
                f32x4 o = mfma16(pack4(at), vf, o0 + o1);
#pragma unroll
                for (int i = 0; i < 8; ++i) { const bf16x4 ktf = *(LAS bf16x4*)(KT + (c * 128 + 16 * i + v) * 40 + 8 * kq); S[i] = mfma16(ktf, vf, S[i]); }
#pragma unroll
                for (int i = 0; i < 8; ++i) { const f32x4 d = *(LAS f32x4*)(DL + c * 128 + 16 * i + 4 * kq); S[i] = S[i] * d; }
#pragma unroll
                for (int jj = 0; jj < 4; ++jj) OB[(c * 16 + 4 * kq + jj) * 132 + 16 * wave + v] = o[jj];
            }
            __syncthreads();
        }
        { float* so = Sout + (4 * kq) * 128 + 16 * wave + v;
#pragma unroll
        for (int i = 0; i < 8; ++i)
#pragma unroll
            for (int jj = 0; jj < 4; ++jj) so[(16 * i + jj) * 128] = S[i][jj]; }
    }
}

__device__ __forceinline__ f32x16 mfma32(bf16x8 a, bf16x8 b, f32x16 c) { return __builtin_amdgcn_mfma_f32_32x32x16_bf16(a, b, c, 0, 0, 0); }
__device__ __forceinline__ v4i16_t ldtr(const LAS unsigned char* q) { return __builtin_amdgcn_ds_read_tr16_b64_v4i16((LAS v4i16_t*)q); }

__device__ __forceinline__ void attn_unit(LAS unsigned char* lds, const bf16_t* QB, const bf16_t* Kb, const bf16_t* Vb, const bf16_t* ZB, bf16_t* AO, const float* subln,
                                          size_t row0q, int h, int ntiles, int qpos0, int nrg, bool partial, float lam, float osc) {
    int tid = threadIdx.x; asm volatile("" : "+v"(tid));
    const int lane = tid & 63, wave = __builtin_amdgcn_readfirstlane(tid >> 6), rg = wave & 3, mp = wave >> 2, ql = lane & 31, hh = lane >> 5;
    const bool active = rg < nrg;
    const float slope2 = ex2(-(float)(h + 1)) * LOG2E;
    bf16x8 qf[4];
    if (active) {
#pragma unroll
        for (int ks = 0; ks < 4; ++ks) qf[ks] = *(const bf16x8*)(QB + (row0q + rg * 32 + ql) * 1024 + mp * 512 + h * 64 + ks * 16 + hh * 8);
    }
    f32x16 ot[4];
#pragma unroll
    for (int dt = 0; dt < 4; ++dt)
#pragma unroll
        for (int r = 0; r < 16; ++r) ot[dt][r] = 0.f;
    float mrow = 0.f, lrow = 0.f;
    const float qpos = (float)(qpos0 + rg * 32 + ql);
    u32x4 sr[4];
    const int kkey = tid >> 3, kseg = tid & 7, vkey = tid >> 4, vseg = tid & 15;
    const int vsw = (vseg ^ (((vkey & 3) << 2) | ((vkey >> 2) & 3))) * 16;
#define ATT_LOAD(jt) do { \
        sr[0] = *(const u32x4*)(Kb + ((size_t)(jt) * 64 + kkey) * 1024 + h * 64 + kseg * 8); sr[1] = *(const u32x4*)(Kb + ((size_t)(jt) * 64 + kkey) * 1024 + 512 + h * 64 + kseg * 8); \
        sr[2] = *(const u32x4*)(Vb + ((size_t)(jt) * 64 + vkey) * 1024 + h * 128 + vseg * 8); sr[3] = *(const u32x4*)(Vb + ((size_t)(jt) * 64 + vkey + 32) * 1024 + h * 128 + vseg * 8); } while (0)
#define ATT_STORE(buf) do { LAS unsigned char* _b = lds + (buf) * 35840; \
        *(LAS u32x4*)(_b + kkey * 144 + kseg * 16) = sr[0]; *(LAS u32x4*)(_b + 9216 + kkey * 144 + kseg * 16) = sr[1]; \
        *(LAS u32x4*)(_b + 18432 + vkey * 256 + vsw) = sr[2]; *(LAS u32x4*)(_b + 18432 + (vkey + 32) * 256 + vsw) = sr[3]; } while (0)
    ATT_LOAD(ntiles - 1); ATT_STORE(0);
    __syncthreads();
    int vo[4][2];
    { const int fh = (lane >> 2) & 3, cl = 2 * ((lane >> 4) & 1) + ((lane >> 1) & 1);
#pragma unroll
      for (int dt = 0; dt < 4; ++dt)
#pragma unroll
          for (int e = 0; e < 2; ++e) vo[dt][e] = 256 * (4 * hh + fh + 8 * e) + 16 * (((dt ^ fh) << 2) + (cl ^ (hh + 2 * e))) + 8 * (lane & 1); }
#define ATT_LDV(dst, sp) do { const LAS unsigned char* _v = lds + 18432 + buf * 35840 + (((sp) >> 1) * 32 + ((sp) & 1) * 16) * 256; _Pragma("unroll") for (int dt = 0; dt < 4; ++dt) { \
        const v4i16_t lo = ldtr(_v + vo[dt][0]), hi = ldtr(_v + vo[dt][1]); \
        dst[dt][0] = lo[0]; dst[dt][1] = lo[1]; dst[dt][2] = lo[2]; dst[dt][3] = lo[3]; dst[dt][4] = hi[0]; dst[dt][5] = hi[1]; dst[dt][6] = hi[2]; dst[dt][7] = hi[3]; } } while (0)
#define ATT_PACK(pf, kt, s8) do { u32x4 pp; pp[0] = pk2(st[kt][s8 + 0], st[kt][s8 + 1]); pp[1] = pk2(st[kt][s8 + 2], st[kt][s8 + 3]); pp[2] = pk2(st[kt][s8 + 4], st[kt][s8 + 5]); pp[3] = pk2(st[kt][s8 + 6], st[kt][s8 + 7]); pf = __builtin_bit_cast(bf16x8, pp); } while (0)
    for (int it = 0; it < ntiles; ++it) {
        const int jt = ntiles - 1 - it;
        const int buf = it & 1;
        if (it + 1 < ntiles) ATT_LOAD(jt - 1);
        const bool doit = active && !(partial && it == 0 && rg < 2);
        if (doit) {
            const LAS unsigned char* Kt = lds + buf * 35840 + mp * 9216;
            bf16x8 kfr[2][4];
#pragma unroll
            for (int kt = 0; kt < 2; ++kt)
#pragma unroll
                for (int ks = 0; ks < 4; ++ks) kfr[kt][ks] = *(LAS bf16x8*)(Kt + (kt * 32 + ql) * 144 + ks * 32 + hh * 16);
            __builtin_amdgcn_sched_barrier(0);
            f32x16 st[2];
            const float dq = qpos - (float)(jt * 64 + 4 * hh);
            { float nsl = -slope2, nm = -mrow; asm volatile("" : "+v"(nsl), "+v"(nm));
#pragma unroll
              for (int kt = 0; kt < 2; ++kt)
#pragma unroll
                for (int r = 0; r < 16; ++r) st[kt][r] = fmaf(nsl, fabsf(dq - (float)(kt * 32 + (r & 3) + 8 * (r >> 2))), nm); }
            __builtin_amdgcn_s_setprio(3);
#pragma unroll
            for (int ks = 0; ks < 4; ++ks) { st[0] = mfma32(kfr[0][ks], qf[ks], st[0]); st[1] = mfma32(kfr[1][ks], qf[ks], st[1]); }
            __builtin_amdgcn_s_setprio(0);
            bf16x8 vf0[4], vf1[4];
            ATT_LDV(vf0, 0); ATT_LDV(vf1, 1);
            __builtin_amdgcn_sched_barrier(0);
            float mx = fmaxf(st[0][0], st[1][0]);
#pragma unroll
            for (int r = 1; r < 16; ++r) mx = fmaxf(mx, fmaxf(st[0][r], st[1][r]));
            mx = fmaxf(mx, __shfl_xor(mx, 32));
            if (__any(mx > 8.f)) {
                const float up = fmaxf(mx, 0.f), alpha = ex2(-up); mrow += up; lrow *= alpha;
#pragma unroll
                for (int dt = 0; dt < 4; ++dt) ot[dt] = ot[dt] * alpha;
#pragma unroll
                for (int kt = 0; kt < 2; ++kt)
#pragma unroll
                    for (int r = 0; r < 16; ++r) st[kt][r] -= up;
            }
            float ps = 0.f;
#pragma unroll
            for (int kt = 0; kt < 2; ++kt)
#pragma unroll
                for (int r = 0; r < 16; ++r) { const float pv = ex2(st[kt][r]); st[kt][r] = pv; ps += pv; }
            lrow += ps;
            bf16x8 pf;
            __builtin_amdgcn_sched_barrier(0);
            ATT_PACK(pf, 0, 0);
            __builtin_amdgcn_s_setprio(3);
#pragma unroll
            for (int dt = 0; dt < 4; ++dt) ot[dt] = mfma32(vf0[dt], pf, ot[dt]);
            __builtin_amdgcn_s_setprio(0);
            ATT_LDV(vf0, 2);
            ATT_PACK(pf, 0, 8);
            __builtin_amdgcn_sched_barrier(0);
            __builtin_amdgcn_s_setprio(3);
#pragma unroll
            for (int dt = 0; dt < 4; ++dt) ot[dt] = mfma32(vf1[dt], pf, ot[dt]);
            __builtin_amdgcn_s_setprio(0);
            ATT_LDV(vf1, 3);
            ATT_PACK(pf, 1, 0);
            __builtin_amdgcn_sched_barrier(0);
            __builtin_amdgcn_s_setprio(3);
#pragma unroll
            for (int dt = 0; dt < 4; ++dt) ot[dt] = mfma32(vf0[dt], pf, ot[dt]);
            ATT_PACK(pf, 1, 8);
#pragma unroll
            for (int dt = 0; dt < 4; ++dt) ot[dt] = mfma32(vf1[dt], pf, ot[dt]);
            __builtin_amdgcn_s_setprio(0);
        }
        if (it + 1 < ntiles) ATT_STORE(buf ^ 1);
        __syncthreads();
    }
#undef ATT_LDV
#undef ATT_PACK
#undef ATT_LOAD
#undef ATT_STORE
    const float lt = lrow + __shfl_xor(lrow, 32);
    const float inv = 1.f / lt;
    LAS float* EX = (LAS float*)(lds + 71680) + (rg * 32 + ql) * 132;
    if (active && mp == 1) {
        const float sc = inv * lam;
#pragma unroll
        for (int dt = 0; dt < 4; ++dt)
#pragma unroll
            for (int g4 = 0; g4 < 4; ++g4) { f32x4 e; e[0] = ot[dt][4 * g4] * sc; e[1] = ot[dt][4 * g4 + 1] * sc; e[2] = ot[dt][4 * g4 + 2] * sc; e[3] = ot[dt][4 * g4 + 3] * sc; *(LAS f32x4*)(EX + dt * 32 + 8 * g4 + 4 * hh) = e; }
    }
    u32x2 zr[4][4];
    if (active && mp == 0) {
        const size_t row = row0q + rg * 32 + ql;
#pragma unroll
        for (int dt = 0; dt < 4; ++dt)
#pragma unroll
            for (int g4 = 0; g4 < 4; ++g4) zr[dt][g4] = *(const u32x2*)(ZB + row * 1024 + h * 128 + dt * 32 + 8 * g4 + 4 * hh);
    }
    __syncthreads();
    if (active && mp == 0) {
        float ss = 0.f;
#pragma unroll
        for (int dt = 0; dt < 4; ++dt)
#pragma unroll
            for (int g4 = 0; g4 < 4; ++g4) { const f32x4 e = *(LAS f32x4*)(EX + dt * 32 + 8 * g4 + 4 * hh);
#pragma unroll
                for (int i = 0; i < 4; ++i) { const float o = ot[dt][4 * g4 + i] * inv - e[i]; ot[dt][4 * g4 + i] = o; ss += o * o; } }
        ss += __shfl_xor(ss, 32);
        const float rs = rsqrtf(ss * (1.f / 128.f) + EPS) * osc;
        const size_t row = row0q + rg * 32 + ql;
#pragma unroll
        for (int dt = 0; dt < 4; ++dt)
#pragma unroll
            for (int g4 = 0; g4 < 4; ++g4) { const int dv = dt * 32 + 8 * g4 + 4 * hh; const f32x4 w = *(const f32x4*)(subln + dv); const u32x2 z = zr[dt][g4];
                u32x2 o; o[0] = pk2(ot[dt][4 * g4] * rs * w[0] * bflo(z[0]), ot[dt][4 * g4 + 1] * rs * w[1] * bfhi(z[0])); o[1] = pk2(ot[dt][4 * g4 + 2] * rs * w[2] * bflo(z[1]), ot[dt][4 * g4 + 3] * rs * w[3] * bfhi(z[1]));
                *(u32x2*)(AO + row * 1024 + h * 128 + dv) = o; }
    }
}

__device__ __forceinline__ void attn_phase(const Params& p, LAS unsigned char* lds, int j, int l) {
    int lane = threadIdx.x & 63; asm volatile("" : "+v"(lane));
    const int G = gridDim.x;
    const float* lv = p.attn_lambda + j * 256;
    const float s01 = wave_sum(lv[lane] * lv[64 + lane]), s23 = wave_sum(lv[128 + lane] * lv[192 + lane]);
    const float lam_init = 0.8f - 0.6f * expf(-0.3f * (float)l);
    const float lam = expf(s01) - expf(s23) + lam_init, osc = 1.f - lam_init;
    const bf16_t* QB = (const bf16_t*)(p.ws + WS_QB); const bf16_t* KB = (const bf16_t*)(p.ws + WS_KB); const bf16_t* VB = (const bf16_t*)(p.ws + WS_VB); const bf16_t* ZB = (const bf16_t*)(p.ws + WS_ZB);
    const bf16_t* KC = (const bf16_t*)(p.ws + WS_KC) + (size_t)j * 16 * KVS * 1024; const bf16_t* VC = (const bf16_t*)(p.ws + WS_VC) + (size_t)j * 16 * KVS * 1024;
    bf16_t* AO = (bf16_t*)(p.ws + WS_AO);
    const float* subln = p.attn_subln + j * 128;
    const bool bal = (G == 256);
    for (int item = blockIdx.x; item < 384; item += G) {
        if (item < 256) { const int b = item >> 3, h = item & 7;
#pragma unroll 1
            for (int qb = 0; qb < 17; ++qb) {
                int bb = b, hq = h, q = qb;
                if (qb == 16) { if (!(bal && item >= 128)) break; bb = (item - 128) >> 3; hq = (item - 128) & 7; q = 7; }
                else if (bal && item < 128 && qb == 7) continue;
                attn_unit(lds, QB, KB + (size_t)bb * 2048 * 1024, VB + (size_t)bb * 2048 * 1024, ZB, AO, subln, (size_t)bb * 2048 + q * 128, hq, 2 * q + 2, q * 128, 4, true, lam, osc);
            }
        } else { const int it = item - 256, b = it >> 3, h = it & 7;
            attn_unit(lds, QB, KC + (size_t)b * KVS * 1024, VC + (size_t)b * KVS * 1024, ZB, AO, subln, (size_t)MP + b * 64, h, 33, 2048, 2, false, lam, osc);
        }
    }
}

__global__ void __launch_bounds__(512, 2) mega_fwd(Params p) {
    extern __shared__ __attribute__((aligned(16))) unsigned char lds_raw[];
    LAS unsigned char* lds = (LAS unsigned char*)lds_raw;
    cg::grid_group grid = cg::this_grid();
    prologue(p, lds);
    grid.sync();
    bf16_t* XA = (bf16_t*)(p.ws + WS_XA); bf16_t* AO = (bf16_t*)(p.ws + WS_AO);
    float* SSQ = (float*)(p.ws + WS_SSQ); float* OSSQ = (float*)(p.ws + WS_OSSQ);
#pragma unroll 1
    for (int l = 0; l < 4; ++l) {
        const int j = l >> 1; const bool attn = (l & 1) != 0;
        {
            pg8::Gemm g{XA, (const bf16_t*)(p.ws + WS_WTIN) + (size_t)l * 4096 * 1024, MT, 4096, 1024};
            pg8::StaticOrder S; S.init(MT, 4096, (int)gridDim.x, (int)blockIdx.x);
            EpiIn E; E.mode = attn ? 1 : 0; E.j = j; E.ws = p.ws; E.outb = p.out; E.qnb = p.attn_q_norm; E.knb = p.attn_k_norm;
            pg8::gemm_phase<EpiIn, pg8::StaticOrder, false>(lds, g, S, E, nullptr);
        }
        grid.sync();
        if (attn) attn_phase(p, lds, j, l); else gla_phase(p, lds, j);
        grid.sync();
        {
            pg8::Gemm g{AO, (const bf16_t*)(p.ws + WS_WTOUT) + (size_t)l * 1024 * 1024, MT, 1024, 1024};
            pg8::StaticOrder S; S.init(MT, 1024, (int)gridDim.x, (int)blockIdx.x);
            EpiOut E; E.out = l == 3 ? p.out : nullptr; E.XA = XA; E.ssq = SSQ; E.ossq = attn ? nullptr : OSSQ;
            pg8::gemm_phase<EpiOut, pg8::StaticOrder, false>(lds, g, S, E, nullptr);
        }
        if (l < 3) grid.sync();
    }
}

extern "C" void kernel_launch(void* const* d_in, const int* in_sizes, int n_in, void* d_out, int out_size, void* d_ws, size_t ws_size, hipStream_t stream) {
    static int grid = 0;
    if (grid == 0) {
        if (n_in != 16 || ws_size < WS_END) { fprintf(stderr, "kernel_launch: unexpected n_in %d / ws_size %zu\n", n_in, ws_size); grid = -1; return; }
        int dev = 0, cus = 0, per_cu = 0;
        hipGetDevice(&dev); hipDeviceGetAttribute(&cus, hipDeviceAttributeMultiprocessorCount, dev);
        if (hipFuncSetAttribute((const void*)mega_fwd, hipFuncAttributeMaxDynamicSharedMemorySize, LDS_BYTES) != hipSuccess) fprintf(stderr, "kernel_launch: hipFuncSetAttribute failed\n");
        if (hipOccupancyMaxActiveBlocksPerMultiprocessor(&per_cu, (const void*)mega_fwd, 512, LDS_BYTES) != hipSuccess || per_cu < 1) { fprintf(stderr, "kernel_launch: occupancy query gave %d\n", per_cu); per_cu = 1; }
        (void)hipGetLastError();
        grid = cus * per_cu;
    }
    if (grid < 0) return;
    Params p{};
    p.x_prompt = (const float*)d_in[0]; p.x_sample = (const float*)d_in[1]; p.cache_k = (const float*)d_in[2]; p.cache_v = (const float*)d_in[3]; p.state_hgrn = (const float*)d_in[4];
    p.norm_w = (const float*)d_in[5]; p.hgrn_w_in = (const float*)d_in[6]; p.hgrn_lb_logits = (const float*)d_in[7]; p.hgrn_onorm_w = (const float*)d_in[8]; p.hgrn_w_out = (const float*)d_in[9];
    p.attn_w_in = (const float*)d_in[10]; p.attn_q_norm = (const float*)d_in[11]; p.attn_k_norm = (const float*)d_in[12]; p.attn_lambda = (const float*)d_in[13]; p.attn_subln = (const float*)d_in[14];
    p.attn_w_out = (const float*)d_in[15];
    p.out = (float*)d_out; p.ws = (unsigned char*)d_ws;
    void* args[] = {&p};
    hipError_t e = hipLaunchCooperativeKernel((const void*)mega_fwd, dim3(grid), dim3(512), args, LDS_BYTES, stream);
    if (e != hipSuccess) fprintf(stderr, "cooperative launch failed: %s (grid %d)\n", hipGetErrorString(e), grid);
}
```

```cpp
#include <hip/hip_runtime.h>
#include <hip/hip_cooperative_groups.h>
#include <cstdio>
#include <cstdint>
namespace cg = cooperative_groups;
namespace pg8 {
#define PG8_LAS __attribute__((address_space(3)))
typedef unsigned short bf16_t;
typedef short bf16x8 __attribute__((ext_vector_type(8)));
typedef float f32x4 __attribute__((ext_vector_type(4)));
typedef unsigned u32x4 __attribute__((ext_vector_type(4)));
constexpr int BM = 256, BK = 64, HALF = 128, HTB = HALF * BK * 2  , STAGE_BYTES = 8 * HTB, NXCD = 8, WGM = 8;

__host__ __device__ __forceinline__ int lds_byte(int r, int c) { const int st = (r >> 4) * 2 + (c >> 5), rr = r & 15, cc = c & 31, ob = rr * 64 + cc * 2; return st * 1024 + (ob ^ (((ob >> 9) & 1) << 5)); }
__host__ __device__ __forceinline__ void stage_rc(int b, int& R, int& C) { const int st = b / 1024, sb = b % 1024, swz = sb ^ (((sb >> 9) & 1) << 5); R = (st >> 1) * 16 + swz / 64; C = (st & 1) * 32 + (swz % 64) / 2; }
__host__ __device__ __forceinline__ int perm32(int rho) { const int n = rho >> 4, i = rho & 15; return 8 * (i >> 2) + 4 * n + (i & 3); }

struct Unit { int pm, pn; };
struct Gemm { const bf16_t* A; const bf16_t* Bt; int M, N, K; };

struct StaticOrder {
    int nM, nN, nwg, G, c;
    __host__ __device__ void init(int M, int N, int G_, int c_) { nM = M / BM; nN = N / BM; nwg = nM * nN; G = G_; c = c_; }
    __host__ __device__ bool next(int i, Unit& u) const {
        const long L = (long)i * G + c; if (L >= nwg) return false;
        int wgid = (int)L; { const int q = nwg / NXCD, r = nwg % NXCD, xcd = wgid % NXCD, off = wgid / NXCD; wgid = (xcd < r ? xcd * (q + 1) : r * (q + 1) + (xcd - r) * q) + off; }
        const int nig = WGM * nN, gid = wgid / nig, fm = gid * WGM, gsz = (nM - fm) < WGM ? (nM - fm) : WGM;
        u.pm = fm + ((wgid % nig) % gsz); u.pn = (wgid % nig) / gsz; return true;
    }
    __device__ __forceinline__ void a_ready(const Unit&) const {}
    __device__ __forceinline__ void done(const Unit&) const {}
};
__device__ __forceinline__ unsigned cvt_pk_bf16(float lo, float hi) { unsigned r; asm volatile("v_cvt_pk_bf16_f32 %0, %1, %2" : "=v"(r) : "v"(lo), "v"(hi)); return r; }
template <class Epi, class Sched, bool STAMP = false>
__device__ __forceinline__ void gemm_phase(PG8_LAS unsigned char* lds, const Gemm g, const Sched& S, const Epi& E, unsigned long long* stamps) {
    int tid_l = threadIdx.x; asm volatile("" : "+v"(tid_l));
    const int tid = tid_l, wid = __builtin_amdgcn_readfirstlane(tid >> 6), lane = tid & 63, wr = wid >> 2, wc = wid & 3, fr = lane & 15, fq = lane >> 4;
    const int K = g.K, nt = K / BK;
    int ts_lo = 0, ts_hi = 0, nts = 0; const unsigned long long rt_entry = STAMP ? (unsigned long long)wall_clock64() : 0ull;
#define PG8_STAMP() do { if (STAMP && wid == 0 && nts < 64) { const unsigned long long _c = (unsigned long long)clock64(); \
        ts_lo = (lane == nts) ? (int)(unsigned)_c : ts_lo; ts_hi = (lane == nts) ? (int)(unsigned)(_c >> 32) : ts_hi; ++nts; } } while (0)
    PG8_STAMP();
    unsigned voffA[2], voffB[2];
#pragma unroll
    for (int i = 0; i < 2; ++i) { int R, C; stage_rc(tid * 16 + i * 8192, R, C); const int Rb = Epi::PERM ? ((R & ~31) + perm32(R & 31)) : R;
        voffA[i] = (unsigned)(R * K + C) * 2u; voffB[i] = (unsigned)(Rb * K + C) * 2u; }
    const size_t kstep = (size_t)(BK * 2);
    const size_t hstep = (size_t)HALF * K * 2;
    const size_t tstep = 2 * hstep;
    const unsigned ldsw = (unsigned)wid * 1024u;
    const int aoff = lds_byte(wr * 64 + fr, fq * 8), boff = lds_byte(wc * 32 + fr, fq * 8);
#define PG8_SA(b, h) (((b) * 2 + (h)) * HTB)
#define PG8_SB(b, h) ((4 + (b) * 2 + (h)) * HTB)
#define PG8_STAGE(bufoff, gbase, voff) do { _Pragma("unroll") for (int _i = 0; _i < 2; ++_i) \
        __builtin_amdgcn_global_load_lds((const unsigned*)((const char*)(gbase) + (voff)[_i]), (PG8_LAS unsigned*)(lds + (bufoff) + ldsw + _i * 8192), 16, 0, 0); } while (0)
#define PG8_LDA(dst, b, h) do { _Pragma("unroll") for (int m = 0; m < 4; ++m) _Pragma("unroll") for (int k = 0; k < 2; ++k) dst[m][k] = *(const PG8_LAS bf16x8*)(lds + PG8_SA(b, h) + aoff + m * 2048 + k * 1024); } while (0)
#define PG8_LDB(dst, b, h) do { _Pragma("unroll") for (int n = 0; n < 2; ++n) _Pragma("unroll") for (int k = 0; k < 2; ++k) dst[n][k] = *(const PG8_LAS bf16x8*)(lds + PG8_SB(b, h) + boff + n * 2048 + k * 1024); } while (0)
#define PG8_MMA(ai, bj, At, Bt) do { __builtin_amdgcn_s_setprio(1); _Pragma("unroll") for (int m = 0; m < 4; ++m) _Pragma("unroll") for (int n = 0; n < 2; ++n) _Pragma("unroll") for (int k = 0; k < 2; ++k) \
        acc[ai][bj][m][n] = __builtin_amdgcn_mfma_f32_16x16x32_bf16(Bt[n][k], At[m][k], acc[ai][bj][m][n], 0, 0, 0); __builtin_amdgcn_s_setprio(0); } while (0)
#define PG8_WAIT_V(n) asm volatile("s_waitcnt vmcnt(" #n ")" ::: "memory")
#define PG8_WAIT_L(n) asm volatile("s_waitcnt lgkmcnt(" #n ")" ::: "memory")
#define PG8_BAR __builtin_amdgcn_s_barrier()
#define PG8_SCHED __builtin_amdgcn_sched_barrier(0)
    Unit cur, nxt; int ui = 0;
    if (!S.next(0, cur)) return;
    f32x4 acc[2][2][4][2];
#pragma unroll
    for (int a = 0; a < 2; ++a)
#pragma unroll
        for (int b = 0; b < 2; ++b)
#pragma unroll
            for (int m = 0; m < 4; ++m)
#pragma unroll
                for (int n = 0; n < 2; ++n) acc[a][b][m][n] = (f32x4){0.f, 0.f, 0.f, 0.f};
    bf16x8 At[4][2], B0[2][2], B1[2][2];
    const char* cA = (const char*)g.A + (size_t)cur.pm * tstep; const char* cB = (const char*)g.Bt + (size_t)cur.pn * tstep;
    S.a_ready(cur);
    PG8_STAGE(PG8_SB(0, 0), cB, voffB); PG8_STAGE(PG8_SA(0, 0), cA, voffA); PG8_STAGE(PG8_SB(0, 1), cB + hstep, voffB); PG8_STAGE(PG8_SA(0, 1), cA + hstep, voffA);
    if (wr == 1) PG8_BAR;
    PG8_WAIT_V(4); PG8_BAR;
    PG8_STAGE(PG8_SB(1, 0), cB + kstep, voffB); PG8_STAGE(PG8_SA(1, 0), cA + kstep, voffA); PG8_STAGE(PG8_SB(1, 1), cB + hstep + kstep, voffB);
    PG8_WAIT_V(6); PG8_BAR;
    PG8_STAMP();
    for (;;) {
        const bool has_next = S.next(ui + 1, nxt);
        const char* nA = has_next ? (const char*)g.A + (size_t)nxt.pm * tstep : cA; const char* nB = has_next ? (const char*)g.Bt + (size_t)nxt.pn * tstep : cB;
        for (int t = 0; t < nt; t += 2) {
            const bool last = (t == nt - 2);
            const char* a1 = cA + (size_t)(t + 1) * kstep;
            const char* a2 = last ? nA : cA + (size_t)(t + 2) * kstep; const char* b2 = last ? nB : cB + (size_t)(t + 2) * kstep;
            const char* a3 = a2 + kstep; const char* b3 = b2 + kstep;
            if (last && has_next) S.a_ready(nxt);
            PG8_LDB(B0, 0, 0); PG8_SCHED; PG8_LDA(At, 0, 0); PG8_STAGE(PG8_SA(1, 1), a1 + hstep, voffA);
            PG8_WAIT_L(8); PG8_BAR; PG8_WAIT_L(0); PG8_MMA(0, 0, At, B0); PG8_BAR; PG8_SCHED;
            PG8_LDB(B1, 0, 1); PG8_STAGE(PG8_SB(0, 0), b2, voffB);
            PG8_BAR; PG8_WAIT_L(0); PG8_MMA(0, 1, At, B1); PG8_BAR;
            PG8_LDA(At, 0, 1); PG8_STAGE(PG8_SA(0, 0), a2, voffA);
            PG8_BAR; PG8_WAIT_L(0); PG8_MMA(1, 0, At, B0); PG8_BAR; PG8_SCHED;
            PG8_STAGE(PG8_SB(0, 1), b2 + hstep, voffB);
            PG8_WAIT_V(6); PG8_BAR; PG8_MMA(1, 1, At, B1); PG8_BAR;
            PG8_LDB(B0, 1, 0); PG8_SCHED; PG8_LDA(At, 1, 0); PG8_STAGE(PG8_SA(0, 1), a2 + hstep, voffA);
            PG8_WAIT_L(8); PG8_BAR; PG8_WAIT_L(0); PG8_MMA(0, 0, At, B0); PG8_BAR; PG8_SCHED;
            PG8_LDB(B1, 1, 1); PG8_STAGE(PG8_SB(1, 0), b3, voffB);
            PG8_BAR; PG8_WAIT_L(0); PG8_MMA(0, 1, At, B1); PG8_BAR;
            PG8_LDA(At, 1, 1); PG8_STAGE(PG8_SA(1, 0), a3, voffA);
            PG8_BAR; PG8_WAIT_L(0); PG8_MMA(1, 0, At, B0); PG8_BAR; PG8_SCHED;
            PG8_STAGE(PG8_SB(1, 1), b3 + hstep, voffB);
            PG8_WAIT_V(6); PG8_BAR; PG8_MMA(1, 1, At, B1); PG8_BAR;
        }
        PG8_STAMP();
        if constexpr (!Epi::AFTER_DRAIN) { E(acc, cur, wr, wc, fr, fq); S.done(cur); }
        PG8_STAMP();
        if (!has_next) break;
#pragma unroll
        for (int a = 0; a < 2; ++a)
#pragma unroll
            for (int b = 0; b < 2; ++b)
#pragma unroll
                for (int m = 0; m < 4; ++m)
#pragma unroll
                    for (int n = 0; n < 2; ++n) acc[a][b][m][n] = (f32x4){0.f, 0.f, 0.f, 0.f};
        cur = nxt; cA = nA; cB = nB; ++ui;
    }
    PG8_WAIT_V(0);
    if (wr == 0) PG8_BAR;
    PG8_BAR;
    if constexpr (Epi::AFTER_DRAIN) { E.fused(acc, cur, wr, wc, fr, fq, lds, wid, lane); S.done(cur); }
    PG8_STAMP();
    if (STAMP && wid == 0) { stamps[lane] = lane < nts ? (((unsigned long long)(unsigned)ts_hi << 32) | (unsigned)ts_lo) : 0ull;
        if (lane == 62) stamps[62] = rt_entry; if (lane == 63) stamps[63] = (unsigned long long)wall_clock64(); }
#undef PG8_STAMP
#undef PG8_SA
#undef PG8_SB
#undef PG8_STAGE
#undef PG8_LDA
#undef PG8_LDB
#undef PG8_MMA
#undef PG8_WAIT_V
#undef PG8_WAIT_L
#undef PG8_BAR
#undef PG8_SCHED
}
}

#define LAS __attribute__((address_space(3)))
using pg8::bf16_t; using pg8::bf16x8; using pg8::f32x4; using pg8::u32x4;
typedef short bf16x4 __attribute__((ext_vector_type(4)));
typedef float f32x16 __attribute__((ext_vector_type(16)));
typedef unsigned u32x2 __attribute__((ext_vector_type(2)));
typedef short v4i16_t __attribute__((ext_vector_type(4)));

constexpr int DM = 1024, MP = 65536, MS = 1024, MT = MP + MS, KVS = 2112;
constexpr float EPS = 1e-6f, LOG2E = 1.4426950408889634f;
constexpr size_t O_YP = 0, O_YS = 67108864, O_KP = 68157440, O_VP = 202375168, O_KS = 336592896, O_VS = 338690048, O_SP = 340787200, O_SS = 349175808;
constexpr size_t MiB = 1u << 20;
constexpr size_t WS_WTIN = 0, WS_WTOUT = 32 * MiB, WS_LB = 40 * MiB, WS_SSQ = 41 * MiB, WS_OSSQ = 46 * MiB, WS_XA = 64 * MiB, WS_QB = 200 * MiB, WS_KB = 336 * MiB,
                 WS_VB = 472 * MiB, WS_ZB = 608 * MiB, WS_AO = 744 * MiB, WS_KC = 880 * MiB, WS_VC = 1016 * MiB, WS_END = 1152 * MiB;
constexpr int LDS_BYTES = 147456;

struct Params {
    const float *x_prompt, *x_sample, *cache_k, *cache_v, *state_hgrn, *norm_w, *hgrn_w_in, *hgrn_lb_logits, *hgrn_onorm_w, *hgrn_w_out,
                *attn_w_in, *attn_q_norm, *attn_k_norm, *attn_lambda, *attn_subln, *attn_w_out;
    float* out; unsigned char* ws;
};

__device__ __forceinline__ unsigned pk2(float lo, float hi) { typedef float f2 __attribute__((ext_vector_type(2))); typedef __bf16 b2 __attribute__((ext_vector_type(2)));
    f2 v = {lo, hi}; b2 b = __builtin_convertvector(v, b2); return __builtin_bit_cast(unsigned, b); }
__device__ __forceinline__ float bflo(unsigned u) { return __uint_as_float(u << 16); }
__device__ __forceinline__ float bfhi(unsigned u) { return __uint_as_float(u & 0xffff0000u); }
__device__ __forceinline__ float wave_sum(float v) {
#pragma unroll
    for (int o = 32; o > 0; o >>= 1) v += __shfl_xor(v, o);
    return v; }
__device__ __forceinline__ float ex2(float x) { return __builtin_amdgcn_exp2f(x); }
__device__ __forceinline__ u32x4 pack8(f32x4 a, f32x4 b) { u32x4 r; r[0] = pk2(a[0], a[1]); r[1] = pk2(a[2], a[3]); r[2] = pk2(b[0], b[1]); r[3] = pk2(b[2], b[3]); return r; }

struct EpiIn {
    static constexpr bool PERM = true, AFTER_DRAIN = false;
    int mode, j;
    unsigned char* ws; float* outb; const float* qnb; const float* knb;
    __device__ __forceinline__ void operator()(const f32x4 (&acc)[2][2][4][2], const pg8::Unit& u, int wr, int wc, int fr, int fq) const {
        const float* ssq = (const float*)(ws + WS_SSQ); const float* lb = (const float*)(ws + WS_LB) + j * 1024; const float* qn = qnb + j * 64; const float* kn = knb + j * 64;
        bf16_t* QB = (bf16_t*)(ws + WS_QB); bf16_t* KB = (bf16_t*)(ws + WS_KB); bf16_t* VB = (bf16_t*)(ws + WS_VB); bf16_t* ZB = (bf16_t*)(ws + WS_ZB);
        bf16_t* KC = (bf16_t*)(ws + WS_KC) + (size_t)j * 16 * KVS * 1024; bf16_t* VC = (bf16_t*)(ws + WS_VC) + (size_t)j * 16 * KVS * 1024;
        float* okp = outb + O_KP + (size_t)j * MP * 1024; float* ovp = outb + O_VP + (size_t)j * MP * 1024; float* oks = outb + O_KS + (size_t)j * MS * 1024; float* ovs = outb + O_VS + (size_t)j * MS * 1024;
        const int region = u.pn >> 2, pg = u.pn & 3;
        const int cb = pg * 256 + wc * 64 + 8 * fq;
        const bool samp = u.pm >= 256;
        float rsv[2][4];
#pragma unroll
        for (int ai = 0; ai < 2; ++ai)
#pragma unroll
            for (int m = 0; m < 4; ++m) { const int row = u.pm * 256 + ai * 128 + wr * 64 + m * 16 + fr;
                const f32x4 s4 = *(const f32x4*)(ssq + (size_t)row * 16 + 4 * fq); rsv[ai][m] = (s4[0] + s4[1]) + (s4[2] + s4[3]); }
#pragma unroll
        for (int ai = 0; ai < 2; ++ai)
#pragma unroll
            for (int m = 0; m < 4; ++m) { float t = rsv[ai][m]; t += __shfl_xor(t, 16); t += __shfl_xor(t, 32); rsv[ai][m] = rsqrtf(t * (1.f / 1024.f) + EPS); }
        f32x4 wq[2][2];
        { const float* wb = mode == 0 ? lb + cb : (region == 0 ? qn : kn) + 8 * fq;
#pragma unroll
          for (int bj = 0; bj < 2; ++bj)
#pragma unroll
              for (int n = 0; n < 2; ++n) wq[bj][n] = *(const f32x4*)(wb + 32 * bj + 4 * n); }
#pragma unroll
        for (int ai = 0; ai < 2; ++ai)
#pragma unroll
            for (int m = 0; m < 4; ++m) {
                const int row = u.pm * 256 + ai * 128 + wr * 64 + m * 16 + fr;
                const float rs = rsv[ai][m];
                f32x4 v[2][2];
#pragma unroll
                for (int bj = 0; bj < 2; ++bj)
#pragma unroll
                    for (int n = 0; n < 2; ++n) v[bj][n] = acc[ai][bj][m][n] * rs;
                if (region == 3) {
#pragma unroll
                    for (int bj = 0; bj < 2; ++bj) {
#pragma unroll
                        for (int n = 0; n < 2; ++n)
#pragma unroll
                            for (int j = 0; j < 4; ++j) { const float x = v[bj][n][j]; v[bj][n][j] = x * __builtin_amdgcn_rcpf(1.f + ex2(-LOG2E * x)); }
                        *(u32x4*)(ZB + (size_t)row * 1024 + cb + 32 * bj) = pack8(v[bj][0], v[bj][1]);
                    }
                } else if (mode == 0) {
                    if (region == 0) {
#pragma unroll
                        for (int bj = 0; bj < 2; ++bj) *(u32x4*)(QB + (size_t)row * 1024 + cb + 32 * bj) = pack8(v[bj][0] * 0.08838834764831845f, v[bj][1] * 0.08838834764831845f);
                    } else if (region == 1) {
#pragma unroll
                        for (int bj = 0; bj < 2; ++bj) {
#pragma unroll
                            for (int n = 0; n < 2; ++n) { const f32x4 l4 = wq[bj][n];
#pragma unroll
                                for (int j = 0; j < 4; ++j) { const float sg = __builtin_amdgcn_rcpf(1.f + ex2(-LOG2E * v[bj][n][j])); const float f = l4[j] + (1.f - l4[j]) * sg; v[bj][n][j] = __builtin_amdgcn_logf(f); } }
                            *(u32x4*)(KB + (size_t)row * 1024 + cb + 32 * bj) = pack8(v[bj][0], v[bj][1]);
                        }
                    } else {
#pragma unroll
                        for (int bj = 0; bj < 2; ++bj) *(u32x4*)(VB + (size_t)row * 1024 + cb + 32 * bj) = pack8(v[bj][0], v[bj][1]);
                    }
                } else {
                    const int srow = row - MP;
                    const size_t crow = samp ? (size_t)(srow >> 6) * KVS + 2048 + (srow & 63) : 0;
                    if (region <= 1) {
                        float ss = 0.f;
#pragma unroll
                        for (int bj = 0; bj < 2; ++bj)
#pragma unroll
                            for (int n = 0; n < 2; ++n)
#pragma unroll
                                for (int j = 0; j < 4; ++j) ss += v[bj][n][j] * v[bj][n][j];
                        ss += __shfl_xor(ss, 16); ss += __shfl_xor(ss, 32);
                        float r2 = rsqrtf(ss * (1.f / 64.f) + EPS);
                        if (region == 0) r2 *= 0.125f * LOG2E;
#pragma unroll
                        for (int bj = 0; bj < 2; ++bj)
#pragma unroll
                            for (int n = 0; n < 2; ++n) v[bj][n] = v[bj][n] * wq[bj][n] * r2;
                        if (region == 0) {
#pragma unroll
                            for (int bj = 0; bj < 2; ++bj) *(u32x4*)(QB + (size_t)row * 1024 + cb + 32 * bj) = pack8(v[bj][0], v[bj][1]);
                        } else {
                            float* of = samp ? oks + (size_t)srow * 1024 : okp + (size_t)row * 1024;
                            bf16_t* ob = samp ? KC + crow * 1024 : KB + (size_t)row * 1024;
#pragma unroll
                            for (int bj = 0; bj < 2; ++bj) { __builtin_nontemporal_store(v[bj][0], (f32x4*)(of + cb + 32 * bj)); __builtin_nontemporal_store(v[bj][1], (f32x4*)(of + cb + 32 * bj + 4)); *(u32x4*)(ob + cb + 32 * bj) = pack8(v[bj][0], v[bj][1]); }
                        }
                    } else {
                        float* of = samp ? ovs + (size_t)srow * 1024 : ovp + (size_t)row * 1024;
                        bf16_t* ob = samp ? VC + crow * 1024 : VB + (size_t)row * 1024;
#pragma unroll
                        for (int bj = 0; bj < 2; ++bj) { __builtin_nontemporal_store(v[bj][0], (f32x4*)(of + cb + 32 * bj)); __builtin_nontemporal_store(v[bj][1], (f32x4*)(of + cb + 32 * bj + 4)); *(u32x4*)(ob + cb + 32 * bj) = pack8(v[bj][0], v[bj][1]); }
                    }
                }
            }
    }
};

struct EpiOut {
    static constexpr bool PERM = true, AFTER_DRAIN = false;
    float* out;
    bf16_t* XA;
    float* ssq;
    const float* ossq;
    __device__ __forceinline__ void operator()(const f32x4 (&acc)[2][2][4][2], const pg8::Unit& u, int wr, int wc, int fr, int fq) const {
        const int cb = u.pn * 256 + wc * 32 + 8 * fq;
        float rsv[8];
        if (ossq) {
#pragma unroll
            for (int r = 0; r < 8; ++r) { const int row = u.pm * 256 + (r >> 2) * 128 + wr * 64 + (r & 3) * 16 + fr;
                const f32x4 s4 = *(const f32x4*)(ossq + (size_t)row * 8 + 4 * (fq & 1)); rsv[r] = (s4[0] + s4[1]) + (s4[2] + s4[3]); }
#pragma unroll
            for (int r = 0; r < 8; ++r) { float t = rsv[r]; t += __shfl_xor(t, 16); rsv[r] = rsqrtf(t * (1.f / 1024.f) + EPS); }
        } else {
#pragma unroll
            for (int r = 0; r < 8; ++r) rsv[r] = 1.f;
        }
        u32x4 xq[4][2];
#pragma unroll
        for (int r = 0; r < 3; ++r) { const int row = u.pm * 256 + (r >> 2) * 128 + wr * 64 + (r & 3) * 16 + fr;
#pragma unroll
            for (int bj = 0; bj < 2; ++bj) xq[r][bj] = *(const u32x4*)(XA + (size_t)row * 1024 + cb + 128 * bj); }
#pragma unroll
        for (int r = 0; r < 8; ++r) {
            const int ai = r >> 2, m = r & 3;
            const int row = u.pm * 256 + ai * 128 + wr * 64 + m * 16 + fr;
            if (r + 3 < 8) { const int rn = r + 3, rown = u.pm * 256 + (rn >> 2) * 128 + wr * 64 + (rn & 3) * 16 + fr;
#pragma unroll
                for (int bj = 0; bj < 2; ++bj) xq[rn & 3][bj] = *(const u32x4*)(XA + (size_t)rown * 1024 + cb + 128 * bj); }
            const u32x4* xc = xq[r & 3];
            const float rs = rsv[r];
            float part = 0.f;
#pragma unroll
            for (int bj = 0; bj < 2; ++bj) {
                const int c = cb + 128 * bj;
                f32x4 x0, x1; x0[0] = bflo(xc[bj][0]); x0[1] = bfhi(xc[bj][0]); x0[2] = bflo(xc[bj][1]); x0[3] = bfhi(xc[bj][1]); x1[0] = bflo(xc[bj][2]); x1[1] = bfhi(xc[bj][2]); x1[2] = bflo(xc[bj][3]); x1[3] = bfhi(xc[bj][3]);
                const f32x4 y0 = x0 + acc[ai][bj][m][0] * rs, y1 = x1 + acc[ai][bj][m][1] * rs;
                if (out) { __builtin_nontemporal_store(y0, (f32x4*)(out + (size_t)row * 1024 + c)); __builtin_nontemporal_store(y1, (f32x4*)(out + (size_t)row * 1024 + c + 4)); }
                *(u32x4*)(XA + (size_t)row * 1024 + c) = pack8(y0, y1);
#pragma unroll
                for (int j = 0; j < 4; ++j) part += y0[j] * y0[j] + y1[j] * y1[j];
            }
            part += __shfl_xor(part, 16); part += __shfl_xor(part, 32);
            if (fq == 0) ssq[(size_t)row * 16 + u.pn * 4 + wc] = part;
        }
    }
};

__device__ __forceinline__ void phase_skew(int k) {
    const unsigned long long t0 = __builtin_amdgcn_s_memrealtime(); while (__builtin_amdgcn_s_memrealtime() - t0 < (unsigned long long)(k * 600)) __builtin_amdgcn_s_sleep(32);
}

__device__ __forceinline__ void prologue(const Params& p, LAS unsigned char* lds) {
    int tid = threadIdx.x; asm volatile("" : "+v"(tid));
    const int G = gridDim.x, bx = blockIdx.x, wave = tid >> 6, lane = tid & 63;
    LAS float* ts = (LAS float*)lds;
    bf16_t* wtin = (bf16_t*)(p.ws + WS_WTIN); bf16_t* wtout = (bf16_t*)(p.ws + WS_WTOUT);
    for (int tile = bx; tile < 5120; tile += G) {
        const float* W; bf16_t* WT; int N, ntile, ktile; const float* nw = nullptr; bool perm;
        if (tile < 4096) { const int l = tile >> 10, t = tile & 1023; ntile = t >> 3; ktile = t & 7; N = 4096; perm = true;
            W = ((l & 1) ? p.attn_w_in : p.hgrn_w_in) + (size_t)(l >> 1) * 1024 * 4096; WT = wtin + (size_t)l * 4096 * 1024; nw = p.norm_w + l * 1024; }
        else { const int t2 = tile - 4096, l = t2 >> 8, t = t2 & 255; ntile = t >> 3; ktile = t & 7; N = 1024; perm = false;
            W = ((l & 1) ? p.attn_w_out : p.hgrn_w_out) + (size_t)(l >> 1) * 1024 * 1024; WT = wtout + (size_t)l * 1024 * 1024; }
        const int vcol0 = ntile * 32, k0 = ktile * 128;
        int real0 = vcol0;
        if (perm) { const int region = vcol0 >> 10, rv = vcol0 & 1023, pg = rv >> 8, rem = rv & 255, bj = rem >> 7, wc = (rem & 127) >> 5; real0 = region * 1024 + pg * 256 + wc * 64 + bj * 32; }
#pragma unroll
        for (int i = 0; i < 2; ++i) { const int k = (tid >> 3) + 64 * i, c4 = (tid & 7) * 4;
            const f32x4 v = *(const f32x4*)(W + (size_t)(k0 + k) * N + real0 + c4); const float s = nw ? nw[k0 + k] : 1.f;
#pragma unroll
            for (int e = 0; e < 4; ++e) ts[k * 33 + c4 + e] = v[e] * s; }
        __syncthreads();
        { const int n = tid >> 4, ks = (tid & 15) * 8; f32x4 a, b;
#pragma unroll
            for (int e = 0; e < 4; ++e) { a[e] = ts[(ks + e) * 33 + n]; b[e] = ts[(ks + 4 + e) * 33 + n]; }
            *(u32x4*)(WT + (size_t)(vcol0 + n) * 1024 + k0 + ks) = pack8(a, b); }
        __syncthreads();
    }
    bf16_t* XA = (bf16_t*)(p.ws + WS_XA); float* SSQ = (float*)(p.ws + WS_SSQ);
    for (int row = bx * 8 + wave; row < MT; row += G * 8) {
        const float* xr = row < MP ? p.x_prompt + (size_t)row * 1024 : p.x_sample + (size_t)(row - MP) * 1024;
        float ss = 0.f;
#pragma unroll
        for (int i = 0; i < 4; ++i) { const f32x4 v = *(const f32x4*)(xr + (lane + 64 * i) * 4); ss += v[0] * v[0] + v[1] * v[1] + v[2] * v[2] + v[3] * v[3];
            u32x2 o; o[0] = pk2(v[0], v[1]); o[1] = pk2(v[2], v[3]); *(u32x2*)(XA + (size_t)row * 1024 + (lane + 64 * i) * 4) = o; }
        ss = wave_sum(ss);
        if (lane < 16) SSQ[(size_t)row * 16 + lane] = lane == 0 ? ss : 0.f;
    }
    { bf16_t* KC = (bf16_t*)(p.ws + WS_KC); bf16_t* VC = (bf16_t*)(p.ws + WS_VC);
      const size_t n8 = (size_t)2 * 16 * 2048 * 1024 / 8;
      for (size_t i0 = (size_t)bx * 2048 + tid; i0 < 2 * n8; i0 += (size_t)G * 2048) {
          f32x4 va[4], vb[4]; bf16_t* dst[4];
#pragma unroll
          for (int q = 0; q < 4; ++q) { const size_t i = i0 + 512 * q; const bool wh = i >= n8; const size_t e = (wh ? i - n8 : i) * 8; const size_t jb = e >> 21, rem = e & ((1u << 21) - 1);
              const float* src = (wh ? p.cache_v : p.cache_k) + e; dst[q] = (wh ? VC : KC) + jb * ((size_t)KVS * 1024) + rem;
              va[q] = __builtin_nontemporal_load((const f32x4*)src); vb[q] = __builtin_nontemporal_load((const f32x4*)src + 1); }
#pragma unroll
          for (int q = 0; q < 4; ++q) *(u32x4*)dst[q] = pack8(va[q], vb[q]);
      } }
    if (bx == 0) { float* LB = (float*)(p.ws + WS_LB);
        for (int c = tid; c < 1024; c += 512) { const float l0 = p.hgrn_lb_logits[c], l1 = p.hgrn_lb_logits[1024 + c]; LB[c] = 0.f; LB[1024 + c] = 1.f / (1.f + expf(l0 - l1)); } }
}

__device__ __forceinline__ f32x4 mfma16(bf16x4 a, bf16x4 b, f32x4 c) { return __builtin_amdgcn_mfma_f32_16x16x16bf16_1k(a, b, c, 0, 0, 0); }
__device__ __forceinline__ bf16x4 pack4(f32x4 a) { u32x2 r; r[0] = pk2(a[0], a[1]); r[1] = pk2(a[2], a[3]); return __builtin_bit_cast(bf16x4, r); }

__device__ __forceinline__ void gla_phase(const Params& p, LAS unsigned char* lds, int j) {
    int tid = threadIdx.x; asm volatile("" : "+v"(tid));
    const int lane = tid & 63, wave = __builtin_amdgcn_readfirstlane(tid >> 6), G = gridDim.x;
    LAS unsigned char* QH = lds; LAS unsigned char* KH = lds + 17408; LAS unsigned char* KT = lds + 34816; LAS unsigned char* VS = lds + 55296;
    LAS float* OB = (LAS float*)(lds + 72704); LAS float* DL = (LAS float*)(lds + 106496);
    const bf16_t* QB = (const bf16_t*)(p.ws + WS_QB); const bf16_t* GB = (const bf16_t*)(p.ws + WS_KB); const bf16_t* VB = (const bf16_t*)(p.ws + WS_VB); const bf16_t* ZB = (const bf16_t*)(p.ws + WS_ZB);
    bf16_t* AO = (bf16_t*)(p.ws + WS_AO); float* OSSQ = (float*)(p.ws + WS_OSSQ);
    for (int item = blockIdx.x; item < 384; item += G) {
        int lane_l = lane; asm volatile("" : "+v"(lane_l));
        const int v = lane_l & 15, kq = lane_l >> 4;
        const int tv = (wave - 4) * 64 + lane_l;
        int b, h, T; size_t row0; const float* S0; float* Sout;
        if (item < 256) { b = item >> 3; h = item & 7; T = 2048; row0 = (size_t)b * 2048; S0 = nullptr; Sout = p.out + O_SP + ((size_t)(j * 32 + b) * 8 + h) * 16384; }
        else { const int it = item - 256; b = it >> 3; h = it & 7; T = 64; row0 = (size_t)MP + b * 64; S0 = p.state_hgrn + ((size_t)(j * 16 + b) * 8 + h) * 16384; Sout = p.out + O_SS + ((size_t)(j * 16 + b) * 8 + h) * 16384; }
        f32x4 S[8];
#pragma unroll
        for (int i = 0; i < 8; ++i) S[i] = (f32x4){0.f, 0.f, 0.f, 0.f};
        if (S0) {
            const float* sp = S0 + (4 * kq) * 128 + 16 * wave + v;
#pragma unroll
            for (int i = 0; i < 8; ++i)
#pragma unroll
                for (int jj = 0; jj < 4; ++jj) S[i][jj] = sp[(16 * i + jj) * 128];
        }
        const int nsteps = T >> 6;
        unsigned rq[16], rg[16]; u32x4 rv[4], rz[4]; f32x4 ow0, ow1;
        const size_t hb = (size_t)h * 128;
        if (wave < 4) {
#pragma unroll
            for (int t = 0; t < 16; ++t) { const size_t r = row0 + wave * 16 + t; rq[t] = *(const unsigned*)(QB + r * 1024 + hb + 2 * lane); rg[t] = *(const unsigned*)(GB + r * 1024 + hb + 2 * lane); }
        } else {
#pragma unroll
            for (int i = 0; i < 4; ++i) { const int idx = tv + 256 * i; rv[i] = *(const u32x4*)(VB + (row0 + (idx >> 4)) * 1024 + hb + (idx & 15) * 8); }
            ow0 = *(const f32x4*)(p.hgrn_onorm_w + j * 1024 + hb + (tv & 15) * 8); ow1 = *(const f32x4*)(p.hgrn_onorm_w + j * 1024 + hb + (tv & 15) * 8 + 4);
        }
        for (int s = 0; s <= nsteps; ++s) {
            if (wave < 4) {
                if (s < nsteps) {
                    float e0 = 1.f, e1 = 1.f;
#pragma unroll
                    for (int t = 0; t < 16; ++t) {
                        const unsigned q2 = rq[t], g2 = rg[t];
                        const float fa = ex2(bflo(g2)), fb = ex2(bfhi(g2));
                        e0 *= fa; e1 *= fb;
                        const float qa = bflo(q2) * e0, qb = bfhi(q2) * e1;
                        const float ka = (1.f - fa) * __builtin_amdgcn_rcpf(fmaxf(e0, 7.5e-37f)), kb = (1.f - fb) * __builtin_amdgcn_rcpf(fmaxf(e1, 7.5e-37f));
                        const int row = wave * 16 + t;
                        *(LAS unsigned*)(QH + row * 272 + lane * 4) = pk2(qa, qb);
                        const unsigned kk = pk2(ka, kb);
                        *(LAS unsigned*)(KH + row * 272 + lane * 4) = kk;
                        *(LAS unsigned short*)(KT + (wave * 128 + 2 * lane) * 40 + t * 2) = (unsigned short)(kk & 0xffffu);
                        *(LAS unsigned short*)(KT + (wave * 128 + 2 * lane + 1) * 40 + t * 2) = (unsigned short)(kk >> 16);
                    }
                    DL[wave * 128 + 2 * lane] = e0; DL[wave * 128 + 2 * lane + 1] = e1;
                    if (s + 1 < nsteps) {
#pragma unroll
                        for (int t = 0; t < 16; ++t) { const size_t r = row0 + (s + 1) * 64 + wave * 16 + t; rq[t] = *(const unsigned*)(QB + r * 1024 + hb + 2 * lane); rg[t] = *(const unsigned*)(GB + r * 1024 + hb + 2 * lane); }
                    }
                }
            } else {
                if (s > 0) {
#pragma unroll
                    for (int i = 0; i < 4; ++i) { const int idx = tv + 256 * i, r = idx >> 4, sg = idx & 15;
                        const f32x4 o0 = *(LAS f32x4*)(OB + r * 132 + sg * 8), o1 = *(LAS f32x4*)(OB + r * 132 + sg * 8 + 4);
                        const u32x4 z = rz[i];
                        f32x4 a0, a1;
                        a0[0] = o0[0] * ow0[0] * bflo(z[0]); a0[1] = o0[1] * ow0[1] * bfhi(z[0]); a0[2] = o0[2] * ow0[2] * bflo(z[1]); a0[3] = o0[3] * ow0[3] * bfhi(z[1]);
                        a1[0] = o1[0] * ow1[0] * bflo(z[2]); a1[1] = o1[1] * ow1[1] * bfhi(z[2]); a1[2] = o1[2] * ow1[2] * bflo(z[3]); a1[3] = o1[3] * ow1[3] * bfhi(z[3]);
                        const size_t grow = row0 + (size_t)(s - 1) * 64 + r;
                        *(u32x4*)(AO + grow * 1024 + hb + sg * 8) = pack8(a0, a1);
                        float ss = o0[0] * o0[0] + o0[1] * o0[1] + o0[2] * o0[2] + o0[3] * o0[3] + o1[0] * o1[0] + o1[1] * o1[1] + o1[2] * o1[2] + o1[3] * o1[3];
                        ss += __shfl_xor(ss, 1); ss += __shfl_xor(ss, 2); ss += __shfl_xor(ss, 4); ss += __shfl_xor(ss, 8);
                        if (sg == 0) OSSQ[grow * 8 + h] = ss; }
                }
                if (s < nsteps) {
#pragma unroll
                    for (int i = 0; i < 4; ++i) { const int idx = tv + 256 * i; *(LAS u32x4*)(VS + (idx >> 4) * 272 + (idx & 15) * 16) = rv[i]; }
#pragma unroll
                    for (int i = 0; i < 4; ++i) { const int idx = tv + 256 * i; rz[i] = *(const u32x4*)(ZB + (row0 + (size_t)s * 64 + (idx >> 4)) * 1024 + hb + (idx & 15) * 8); }
                    if (s + 1 < nsteps) {
#pragma unroll
                        for (int i = 0; i < 4; ++i) { const int idx = tv + 256 * i; rv[i] = *(const u32x4*)(VB + (row0 + (size_t)(s + 1) * 64 + (idx >> 4)) * 1024 + hb + (idx & 15) * 8); }
                    }
                }
            }
            __syncthreads();
            if (s == nsteps) break;
#pragma unroll
            for (int c = 0; c < 4; ++c) {
                bf16x4 qf[8], kf[8];
#pragma unroll
                for (int i = 0; i < 8; ++i) { qf[i] = *(LAS bf16x4*)(QH + (c * 16 + v) * 272 + (16 * i + 4 * kq) * 2); kf[i] = *(LAS bf16x4*)(KH + (c * 16 + v) * 272 + (16 * i + 4 * kq) * 2); }
                bf16x4 vf;
#pragma unroll
                for (int jj = 0; jj < 4; ++jj) vf[jj] = *(LAS short*)(VS + (c * 16 + 4 * kq + jj) * 272 + (16 * wave + v) * 2);
                f32x4 o0 = {0.f, 0.f, 0.f, 0.f}, o1 = o0, a0 = o0, a1 = o0;
#pragma unroll
                for (int i = 0; i < 8; i += 2) { o0 = mfma16(qf[i], pack4(S[i]), o0); o1 = mfma16(qf[i + 1], pack4(S[i + 1]), o1); a0 = mfma16(kf[i], qf[i], a0); a1 = mfma16(kf[i + 1], qf[i + 1], a1); }
                f32x4 at = a0 + a1;
#pragma unroll
                for (int jj = 0; jj < 4; ++jj) if (4 * kq + jj > v) at[jj] = 0.f;
                f32x4 o = mfma16(pack4(at), vf, o0 + o1);
#pragma unroll
                for (int i = 0; i < 8; ++i) { const bf16x4 ktf = *(LAS bf16x4*)(KT + (c * 128 + 16 * i + v) * 40 + 8 * kq); S[i] = mfma16(ktf, vf, S[i]); }
#pragma unroll
                for (int i = 0; i < 8; ++i) { const f32x4 d = *(LAS f32x4*)(DL + c * 128 + 16 * i + 4 * kq); S[i] = S[i] * d; }
#pragma unroll
                for (int jj = 0; jj < 4; ++jj) OB[(c * 16 + 4 * kq + jj) * 132 + 16 * wave + v] = o[jj];
            }
            __syncthreads();
        }
        { float* so = Sout + (4 * kq) * 128 + 16 * wave + v;
#pragma unroll
        for (int i = 0; i < 8; ++i)
#pragma unroll
            for (int jj = 0; jj < 4; ++jj) so[(16 * i + jj) * 128] = S[i][jj]; }
    }
}

__device__ __forceinline__ f32x16 mfma32(bf16x8 a, bf16x8 b, f32x16 c) { return __builtin_amdgcn_mfma_f32_32x32x16_bf16(a, b, c, 0, 0, 0); }
__device__ __forceinline__ v4i16_t ldtr(const LAS unsigned char* q) { return __builtin_amdgcn_ds_read_tr16_b64_v4i16((LAS v4i16_t*)q); }

__device__ __forceinline__ void attn_unit(LAS unsigned char* lds, const bf16_t* QB, const bf16_t* Kb, const bf16_t* Vb, const bf16_t* ZB, bf16_t* AO, const float* subln,
                                          size_t row0q, int h, int ntiles, int qpos0, int nrg, bool partial, float lam, float osc) {
    int tid = threadIdx.x; asm volatile("" : "+v"(tid));
    const int lane = tid & 63, wave = __builtin_amdgcn_readfirstlane(tid >> 6), rg = wave & 3, mp = wave >> 2, ql = lane & 31, hh = lane >> 5;
    const bool active = rg < nrg;
    const float slope2 = ex2(-(float)(h + 1)) * LOG2E;
    bf16x8 qf[4];
    if (active) {
#pragma unroll
        for (int ks = 0; ks < 4; ++ks) qf[ks] = *(const bf16x8*)(QB + (row0q + rg * 32 + ql) * 1024 + mp * 512 + h * 64 + ks * 16 + hh * 8);
    }
    f32x16 ot[4];
#pragma unroll
    for (int dt = 0; dt < 4; ++dt)
#pragma unroll
        for (int r = 0; r < 16; ++r) ot[dt][r] = 0.f;
    float mrow = 0.f, lrow = 0.f;
    const float qpos = (float)(qpos0 + rg * 32 + ql);
    u32x4 sr[4];
    const int kkey = tid >> 3, kseg = tid & 7, vkey = tid >> 4, vseg = tid & 15;
    const int vsw = (vseg ^ (((vkey & 3) << 2) | ((vkey >> 2) & 3))) * 16;
#define ATT_LOAD(jt) do { \
        sr[0] = *(const u32x4*)(Kb + ((size_t)(jt) * 64 + kkey) * 1024 + h * 64 + kseg * 8); sr[1] = *(const u32x4*)(Kb + ((size_t)(jt) * 64 + kkey) * 1024 + 512 + h * 64 + kseg * 8); \
        sr[2] = *(const u32x4*)(Vb + ((size_t)(jt) * 64 + vkey) * 1024 + h * 128 + vseg * 8); sr[3] = *(const u32x4*)(Vb + ((size_t)(jt) * 64 + vkey + 32) * 1024 + h * 128 + vseg * 8); } while (0)
#define ATT_STORE(buf) do { LAS unsigned char* _b = lds + (buf) * 35840; \
        *(LAS u32x4*)(_b + kkey * 144 + kseg * 16) = sr[0]; *(LAS u32x4*)(_b + 9216 + kkey * 144 + kseg * 16) = sr[1]; \
        *(LAS u32x4*)(_b + 18432 + vkey * 256 + vsw) = sr[2]; *(LAS u32x4*)(_b + 18432 + (vkey + 32) * 256 + vsw) = sr[3]; } while (0)
    ATT_LOAD(ntiles - 1); ATT_STORE(0);
    __syncthreads();
    int vo[4][2];
    { const int fh = (lane >> 2) & 3, cl = 2 * ((lane >> 4) & 1) + ((lane >> 1) & 1);
#pragma unroll
      for (int dt = 0; dt < 4; ++dt)
#pragma unroll
          for (int e = 0; e < 2; ++e) vo[dt][e] = 256 * (4 * hh + fh + 8 * e) + 16 * (((dt ^ fh) << 2) + (cl ^ (hh + 2 * e))) + 8 * (lane & 1); }
#define ATT_LDV(dst, sp) do { const LAS unsigned char* _v = lds + 18432 + buf * 35840 + (((sp) >> 1) * 32 + ((sp) & 1) * 16) * 256; _Pragma("unroll") for (int dt = 0; dt < 4; ++dt) { \
        const v4i16_t lo = ldtr(_v + vo[dt][0]), hi = ldtr(_v + vo[dt][1]); \
        dst[dt][0] = lo[0]; dst[dt][1] = lo[1]; dst[dt][2] = lo[2]; dst[dt][3] = lo[3]; dst[dt][4] = hi[0]; dst[dt][5] = hi[1]; dst[dt][6] = hi[2]; dst[dt][7] = hi[3]; } } while (0)
#define ATT_PACK(pf, kt, s8) do { u32x4 pp; pp[0] = pk2(st[kt][s8 + 0], st[kt][s8 + 1]); pp[1] = pk2(st[kt][s8 + 2], st[kt][s8 + 3]); pp[2] = pk2(st[kt][s8 + 4], st[kt][s8 + 5]); pp[3] = pk2(st[kt][s8 + 6], st[kt][s8 + 7]); pf = __builtin_bit_cast(bf16x8, pp); } while (0)
    for (int it = 0; it < ntiles; ++it) {
        const int jt = ntiles - 1 - it;
        const int buf = it & 1;
        if (it + 1 < ntiles) ATT_LOAD(jt - 1);
        const bool doit = active && !(partial && it == 0 && rg < 2);
        if (doit) {
            const LAS unsigned char* Kt = lds + buf * 35840 + mp * 9216;
            bf16x8 kfr[2][4];
#pragma unroll
            for (int kt = 0; kt < 2; ++kt)
#pragma unroll
                for (int ks = 0; ks < 4; ++ks) kfr[kt][ks] = *(LAS bf16x8*)(Kt + (kt * 32 + ql) * 144 + ks * 32 + hh * 16);
            __builtin_amdgcn_sched_barrier(0);
            f32x16 st[2];
            const float dq = qpos - (float)(jt * 64 + 4 * hh);
            { float nsl = -slope2, nm = -mrow; asm volatile("" : "+v"(nsl), "+v"(nm));
#pragma unroll
              for (int kt = 0; kt < 2; ++kt)
#pragma unroll
                for (int r = 0; r < 16; ++r) st[kt][r] = fmaf(nsl, fabsf(dq - (float)(kt * 32 + (r & 3) + 8 * (r >> 2))), nm); }
            __builtin_amdgcn_s_setprio(3);
#pragma unroll
            for (int ks = 0; ks < 4; ++ks) { st[0] = mfma32(kfr[0][ks], qf[ks], st[0]); st[1] = mfma32(kfr[1][ks], qf[ks], st[1]); }
            __builtin_amdgcn_s_setprio(0);
            bf16x8 vf0[4], vf1[4];
            ATT_LDV(vf0, 0); ATT_LDV(vf1, 1);
            __builtin_amdgcn_sched_barrier(0);
            float mx = fmaxf(st[0][0], st[1][0]);
#pragma unroll
            for (int r = 1; r < 16; ++r) mx = fmaxf(mx, fmaxf(st[0][r], st[1][r]));
            mx = fmaxf(mx, __shfl_xor(mx, 32));
            if (__any(mx > 8.f)) {
                const float up = fmaxf(mx, 0.f), alpha = ex2(-up); mrow += up; lrow *= alpha;
#pragma unroll
                for (int dt = 0; dt < 4; ++dt) ot[dt] = ot[dt] * alpha;
#pragma unroll
                for (int kt = 0; kt < 2; ++kt)
#pragma unroll
                    for (int r = 0; r < 16; ++r) st[kt][r] -= up;
            }
            float ps = 0.f;
#pragma unroll
            for (int kt = 0; kt < 2; ++kt)
#pragma unroll
                for (int r = 0; r < 16; ++r) { const float pv = ex2(st[kt][r]); st[kt][r] = pv; ps += pv; }
            lrow += ps;
            bf16x8 pf;
            __builtin_amdgcn_sched_barrier(0);
            ATT_PACK(pf, 0, 0);
            __builtin_amdgcn_s_setprio(3);
#pragma unroll
            for (int dt = 0; dt < 4; ++dt) ot[dt] = mfma32(vf0[dt], pf, ot[dt]);
            __builtin_amdgcn_s_setprio(0);
            ATT_LDV(vf0, 2);
            ATT_PACK(pf, 0, 8);
            __builtin_amdgcn_sched_barrier(0);
            __builtin_amdgcn_s_setprio(3);
#pragma unroll
            for (int dt = 0; dt < 4; ++dt) ot[dt] = mfma32(vf1[dt], pf, ot[dt]);
            __builtin_amdgcn_s_setprio(0);
            ATT_LDV(vf1, 3);
            ATT_PACK(pf, 1, 0);
            __builtin_amdgcn_sched_barrier(0);
            __builtin_amdgcn_s_setprio(3);
#pragma unroll
            for (int dt = 0; dt < 4; ++dt) ot[dt] = mfma32(vf0[dt], pf, ot[dt]);
            ATT_PACK(pf, 1, 8);
#pragma unroll
            for (int dt = 0; dt < 4; ++dt) ot[dt] = mfma32(vf1[dt], pf, ot[dt]);
            __builtin_amdgcn_s_setprio(0);
        }
        if (it + 1 < ntiles) ATT_STORE(buf ^ 1);
        __syncthreads();
    }
#undef ATT_LDV
#undef ATT_PACK
#undef ATT_LOAD
#undef ATT_STORE
    const float lt = lrow + __shfl_xor(lrow, 32);
    const float inv = 1.f / lt;
    LAS float* EX = (LAS float*)(lds + 71680) + (rg * 32 + ql) * 132;
    if (active && mp == 1) {
        const float sc = inv * lam;
#pragma unroll
        for (int dt = 0; dt < 4; ++dt)
#pragma unroll
            for (int g4 = 0; g4 < 4; ++g4) { f32x4 e; e[0] = ot[dt][4 * g4] * sc; e[1] = ot[dt][4 * g4 + 1] * sc; e[2] = ot[dt][4 * g4 + 2] * sc; e[3] = ot[dt][4 * g4 + 3] * sc; *(LAS f32x4*)(EX + dt * 32 + 8 * g4 + 4 * hh) = e; }
    }
    u32x2 zr[4][4];
    if (active && mp == 0) {
        const size_t row = row0q + rg * 32 + ql;
#pragma unroll
        for (int dt = 0; dt < 4; ++dt)
#pragma unroll
            for (int g4 = 0; g4 < 4; ++g4) zr[dt][g4] = *(const u32x2*)(ZB + row * 1024 + h * 128 + dt * 32 + 8 * g4 + 4 * hh);
    }
    __syncthreads();
    if (active && mp == 0) {
        float ss = 0.f;
#pragma unroll
        for (int dt = 0; dt < 4; ++dt)
#pragma unroll
            for (int g4 = 0; g4 < 4; ++g4) { const f32x4 e = *(LAS f32x4*)(EX + dt * 32 + 8 * g4 + 4 * hh);
#pragma unroll
                for (int i = 0; i < 4; ++i) { const float o = ot[dt][4 * g4 + i] * inv - e[i]; ot[dt][4 * g4 + i] = o; ss += o * o; } }
        ss += __shfl_xor(ss, 32);
        const float rs = rsqrtf(ss * (1.f / 128.f) + EPS) * osc;
        const size_t row = row0q + rg * 32 + ql;
#pragma unroll
        for (int dt = 0; dt < 4; ++dt)
#pragma unroll
            for (int g4 = 0; g4 < 4; ++g4) { const int dv = dt * 32 + 8 * g4 + 4 * hh; const f32x4 w = *(const f32x4*)(subln + dv); const u32x2 z = zr[dt][g4];
                u32x2 o; o[0] = pk2(ot[dt][4 * g4] * rs * w[0] * bflo(z[0]), ot[dt][4 * g4 + 1] * rs * w[1] * bfhi(z[0])); o[1] = pk2(ot[dt][4 * g4 + 2] * rs * w[2] * bflo(z[1]), ot[dt][4 * g4 + 3] * rs * w[3] * bfhi(z[1]));
                *(u32x2*)(AO + row * 1024 + h * 128 + dv) = o; }
    }
}

__device__ __forceinline__ void attn_phase(const Params& p, LAS unsigned char* lds, int j, int l) {
    int lane = threadIdx.x & 63; asm volatile("" : "+v"(lane));
    const int G = gridDim.x;
    const float* lv = p.attn_lambda + j * 256;
    const float s01 = wave_sum(lv[lane] * lv[64 + lane]), s23 = wave_sum(lv[128 + lane] * lv[192 + lane]);
    const float lam_init = 0.8f - 0.6f * expf(-0.3f * (float)l);
    const float lam = expf(s01) - expf(s23) + lam_init, osc = 1.f - lam_init;
    const bf16_t* QB = (const bf16_t*)(p.ws + WS_QB); const bf16_t* KB = (const bf16_t*)(p.ws + WS_KB); const bf16_t* VB = (const bf16_t*)(p.ws + WS_VB); const bf16_t* ZB = (const bf16_t*)(p.ws + WS_ZB);
    const bf16_t* KC = (const bf16_t*)(p.ws + WS_KC) + (size_t)j * 16 * KVS * 1024; const bf16_t* VC = (const bf16_t*)(p.ws + WS_VC) + (size_t)j * 16 * KVS * 1024;
    bf16_t* AO = (bf16_t*)(p.ws + WS_AO);
    const float* subln = p.attn_subln + j * 128;
    const int w = (int)blockIdx.x;
    if (G == 256) {
        const int x = w & 7, idx = w >> 3, gid = x * 4 + (idx >> 3), i = idx & 7;
        const unsigned last = i == 0 ? 0xFFFF0710u : i == 1 ? 0xFFFF0810u : i == 2 ? 0xFF010610u : i == 3 ? 0xFF020510u : i == 4 ? 0xFFFF090Fu : i == 5 ? 0xFFFF0A0Eu : i == 6 ? 0xFFFF0B0Du : 0x0003040Cu;
#pragma unroll 1
        for (int k = 0; k < 18; ++k) {
            const bf16_t* Kp; const bf16_t* Vp; size_t row0q; int hq, nt, qp0, nrg; bool part;
            int q, r = k >> 1;
            if (k < 14) q = (k & 1) ? i : 15 - i;
            else { r = 7; q = (int)((last >> (8 * (k - 14))) & 0xFFu); if (q == 0xFF) break; }
            if (q < 16) { const int pair = gid * 8 + r, bb = pair >> 3; hq = pair & 7;
                Kp = KB + (size_t)bb * 2048 * 1024; Vp = VB + (size_t)bb * 2048 * 1024; row0q = (size_t)bb * 2048 + q * 128; nt = 2 * q + 2; qp0 = q * 128; nrg = 4; part = true; }
            else { const int su = gid * 4 + i, bb = su >> 3; hq = su & 7;
                Kp = KC + (size_t)bb * KVS * 1024; Vp = VC + (size_t)bb * KVS * 1024; row0q = (size_t)MP + bb * 64; nt = 33; qp0 = 2048; nrg = 2; part = false; }
            attn_unit(lds, QB, Kp, Vp, ZB, AO, subln, row0q, hq, nt, qp0, nrg, part, lam, osc);
        }
    } else {
        for (int item = w; item < 384; item += G) {
            if (item < 256) { const int b = item >> 3, h = item & 7;
#pragma unroll 1
                for (int qb = 0; qb < 16; ++qb)
                    attn_unit(lds, QB, KB + (size_t)b * 2048 * 1024, VB + (size_t)b * 2048 * 1024, ZB, AO, subln, (size_t)b * 2048 + qb * 128, h, 2 * qb + 2, qb * 128, 4, true, lam, osc);
            } else { const int it = item - 256, b = it >> 3, h = it & 7;
                attn_unit(lds, QB, KC + (size_t)b * KVS * 1024, VC + (size_t)b * KVS * 1024, ZB, AO, subln, (size_t)MP + b * 64, h, 33, 2048, 2, false, lam, osc);
            }
        }
    }
}

__global__ void __launch_bounds__(512, 2) mega_fwd(Params p) {
    extern __shared__ __attribute__((aligned(16))) unsigned char lds_raw[];
    LAS unsigned char* lds = (LAS unsigned char*)lds_raw;
    cg::grid_group grid = cg::this_grid();
    prologue(p, lds);
    grid.sync();
    bf16_t* XA = (bf16_t*)(p.ws + WS_XA); bf16_t* AO = (bf16_t*)(p.ws + WS_AO);
    float* SSQ = (float*)(p.ws + WS_SSQ); float* OSSQ = (float*)(p.ws + WS_OSSQ);
#pragma unroll 1
    for (int l = 0; l < 4; ++l) {
        const int j = l >> 1; const bool attn = (l & 1) != 0;
        {
            pg8::Gemm g{XA, (const bf16_t*)(p.ws + WS_WTIN) + (size_t)l * 4096 * 1024, MT, 4096, 1024};
            pg8::StaticOrder S; S.init(MT, 4096, (int)gridDim.x, (int)blockIdx.x);
            EpiIn E; E.mode = attn ? 1 : 0; E.j = j; E.ws = p.ws; E.outb = p.out; E.qnb = p.attn_q_norm; E.knb = p.attn_k_norm;
            pg8::gemm_phase<EpiIn, pg8::StaticOrder, false>(lds, g, S, E, nullptr);
        }
        grid.sync();
        if (attn) attn_phase(p, lds, j, l); else gla_phase(p, lds, j);
        grid.sync();
        {
            pg8::Gemm g{AO, (const bf16_t*)(p.ws + WS_WTOUT) + (size_t)l * 1024 * 1024, MT, 1024, 1024};
            pg8::StaticOrder S; S.init(MT, 1024, (int)gridDim.x, (int)blockIdx.x);
            EpiOut E; E.out = l == 3 ? p.out : nullptr; E.XA = XA; E.ssq = SSQ; E.ossq = attn ? nullptr : OSSQ;
            pg8::gemm_phase<EpiOut, pg8::StaticOrder, false>(lds, g, S, E, nullptr);
        }
        if (l < 3) grid.sync();
    }
}

extern "C" void kernel_launch(void* const* d_in, const int* in_sizes, int n_in, void* d_out, int out_size, void* d_ws, size_t ws_size, hipStream_t stream) {
    static int grid = 0;
    if (grid == 0) {
        if (n_in != 16 || ws_size < WS_END) { fprintf(stderr, "kernel_launch: unexpected n_in %d / ws_size %zu\n", n_in, ws_size); grid = -1; return; }
        int dev = 0, cus = 0, per_cu = 0;
        hipGetDevice(&dev); hipDeviceGetAttribute(&cus, hipDeviceAttributeMultiprocessorCount, dev);
        if (hipFuncSetAttribute((const void*)mega_fwd, hipFuncAttributeMaxDynamicSharedMemorySize, LDS_BYTES) != hipSuccess) fprintf(stderr, "kernel_launch: hipFuncSetAttribute failed\n");
        if (hipOccupancyMaxActiveBlocksPerMultiprocessor(&per_cu, (const void*)mega_fwd, 512, LDS_BYTES) != hipSuccess || per_cu < 1) { fprintf(stderr, "kernel_launch: occupancy query gave %d\n", per_cu); per_cu = 1; }
        (void)hipGetLastError();
        grid = cus * per_cu;
    }
    if (grid < 0) return;
    Params p{};
    p.x_prompt = (const float*)d_in[0]; p.x_sample = (const float*)d_in[1]; p.cache_k = (const float*)d_in[2]; p.cache_v = (const float*)d_in[3]; p.state_hgrn = (const float*)d_in[4];
    p.norm_w = (const float*)d_in[5]; p.hgrn_w_in = (const float*)d_in[6]; p.hgrn_lb_logits = (const float*)d_in[7]; p.hgrn_onorm_w = (const float*)d_in[8]; p.hgrn_w_out = (const float*)d_in[9];
    p.attn_w_in = (const float*)d_in[10]; p.attn_q_norm = (const float*)d_in[11]; p.attn_k_norm = (const float*)d_in[12]; p.attn_lambda = (const float*)d_in[13]; p.attn_subln = (const float*)d_in[14];
    p.attn_w_out = (const float*)d_in[15];
    p.out = (float*)d_out; p.ws = (unsigned char*)d_ws;
    void* args[] = {&p};
    hipError_t e = hipLaunchCooperativeKernel((const void*)mega_fwd, dim3(grid), dim3(512), args, LDS_BYTES, stream);
    if (e != hipSuccess) fprintf(stderr, "cooperative launch failed: %s (grid %d)\n", hipGetErrorString(e), grid);
}
```
